# Optimizing an MI355X kernel written in HIP

```python
import math
import jax, jax.numpy as jnp
from jax import lax
import numpy as np

D_MODEL = 1024
BATCH = 2
SEQ = 8192
DEPTH = 1
DEC_BATCH = 128
DEC_SEQ = 4
PAST_LEN = 8192
PAGE_SIZE = 128

ATT_HEAD_DIM = 64
ATT_HEADS = (D_MODEL // 2) // ATT_HEAD_DIM
ATT_KV_HEADS = ATT_HEADS // 4
ATT_GROUP = ATT_HEADS // ATT_KV_HEADS
ATT_WIDTH = ATT_HEADS * ATT_HEAD_DIM
WINDOW = 128
NUM_BUCKETS = 32
MAX_DISTANCE = 128
HG_KEY = 128
HG_VAL = 128
HG_HEADS = (D_MODEL // 2) // HG_VAL
HG_WIDTH = HG_HEADS * HG_VAL
HG_FDIM = HG_HEADS * HG_KEY
HG_CHUNK = 64
MIX_WIDTH = ATT_WIDTH + HG_WIDTH
D_FF = ((8 * D_MODEL // 3 + 127) // 128) * 128
CONV_W = 3
RMS_EPS = 1e-6
SPLITS = (ATT_WIDTH, ATT_KV_HEADS * ATT_HEAD_DIM, ATT_KV_HEADS * ATT_HEAD_DIM,
          HG_FDIM, HG_FDIM, HG_WIDTH, HG_WIDTH)
PROJ_WIDTH = sum(SPLITS)
SPLIT_IDX = [sum(SPLITS[:i + 1]) for i in range(len(SPLITS) - 1)]

kernel_name = 'hymba_swa_sink_hgrn2_convffn_step'


def rms_norm(x, g):
    xf = x.astype(jnp.float32)
    y = xf * lax.rsqrt(jnp.mean(xf * xf, axis=-1, keepdims=True) + RMS_EPS)
    return (y * g.astype(jnp.float32)).astype(x.dtype)


def t5_bucket(dist):
    n = jnp.maximum(dist, 0)
    max_exact = NUM_BUCKETS // 2
    nf = jnp.maximum(n, 1).astype(jnp.float32)
    large = max_exact + (jnp.log(nf / max_exact) / math.log(MAX_DISTANCE / max_exact)
                         * (NUM_BUCKETS - max_exact)).astype(jnp.int32)
    large = jnp.minimum(large, NUM_BUCKETS - 1)
    return jnp.where(n < max_exact, n, large)


def sink_window_attention(q, k, v, dist, valid, rel_bias, sinks):
    nq, nk = dist.shape
    s = jnp.einsum('bnqhgd,bnshd->bnhgqs', q.astype(jnp.float32), k.astype(jnp.float32)) * (ATT_HEAD_DIM ** -0.5)
    bias = rel_bias.astype(jnp.float32)[t5_bucket(dist)]
    bias = bias.reshape(nq, nk, ATT_KV_HEADS, ATT_GROUP).transpose(2, 3, 0, 1)
    mask = valid[:, None, None] & ((dist >= 0) & (dist < WINDOW))
    s = jnp.where(mask, s + bias, -jnp.inf)
    sink = sinks.astype(jnp.float32).reshape(ATT_KV_HEADS, ATT_GROUP)[:, :, None]
    m = jnp.maximum(jnp.max(s, axis=-1), sink)
    p = jnp.exp(s - m[..., None])
    den = jnp.sum(p, axis=-1) + jnp.exp(sink - m)
    o = jnp.einsum('bnhgqs,bnshd->bnqhgd', p, v.astype(jnp.float32))
    return o / den.transpose(0, 1, 4, 2, 3)[..., None]


def attn_prompt(q, k, v, rel_bias, sinks):
    b, s_len = q.shape[:2]
    nb = s_len // WINDOW
    qb = q.reshape(b, nb, WINDOW, ATT_KV_HEADS, ATT_GROUP, ATT_HEAD_DIM)

    def band(t):
        tp = jnp.pad(t, ((0, 0), (WINDOW, 0), (0, 0), (0, 0)))
        tp = tp.reshape(b, nb + 1, WINDOW, ATT_KV_HEADS, ATT_HEAD_DIM)
        return jnp.concatenate([tp[:, :-1], tp[:, 1:]], axis=2)

    qi = jnp.arange(WINDOW)[:, None]
    si = jnp.arange(2 * WINDOW)[None, :]
    dist = WINDOW + qi - si
    valid = (jnp.arange(nb)[:, None, None] * WINDOW - WINDOW + si[None]) >= 0
    o = sink_window_attention(qb, band(k), band(v), dist, valid, rel_bias, sinks)
    return o.reshape(b, s_len, ATT_WIDTH)


def attn_sample(q, k, v, k_buf, v_buf, rel_bias, sinks):
    b, l = q.shape[:2]
    wb = k_buf.shape[1]
    kc = jnp.concatenate([k_buf.astype(k.dtype), k], axis=1)
    vc = jnp.concatenate([v_buf.astype(v.dtype), v], axis=1)
    dist = jnp.arange(l)[:, None] + wb - jnp.arange(wb + l)[None, :]
    valid = jnp.ones((1, 1, wb + l), dtype=bool)
    qb = q.reshape(b, 1, l, ATT_KV_HEADS, ATT_GROUP, ATT_HEAD_DIM)
    o = sink_window_attention(qb, kc[:, None], vc[:, None], dist, valid, rel_bias, sinks)
    return o.reshape(b, l, ATT_WIDTH), kc[:, -wb:], vc[:, -wb:]


def hgrn2_recurrence(q, logf, k, v, s0):
    b, l, h, dk = q.shape
    c = HG_CHUNK if l % HG_CHUNK == 0 else l
    nc = l // c

    def to_chunks(t):
        return t.astype(jnp.float32).reshape(b, nc, c, h, t.shape[-1]).transpose(1, 0, 3, 2, 4)

    causal = jnp.tril(jnp.ones((c, c), dtype=bool))

    def step(s, xs):
        qc, lfc, kc, vc = xs
        cb = jnp.cumsum(lfc, axis=2)
        o = jnp.einsum('bhtk,bhkv->bhtv', qc * jnp.exp(cb), s)
        decay = jnp.exp(jnp.where(causal[:, :, None], cb[:, :, :, None, :] - cb[:, :, None, :, :], -jnp.inf))
        a = jnp.einsum('bhtk,bhtsk,bhsk->bhts', qc, decay, kc)
        o = o + jnp.einsum('bhts,bhsv->bhtv', a, vc)
        bl = cb[:, :, -1:, :]
        s = jnp.exp(bl[:, :, 0])[..., None] * s + jnp.einsum('bhsk,bhsv->bhkv', kc * jnp.exp(bl - cb), vc)
        return s, o

    s_fin, o = lax.scan(step, s0.astype(jnp.float32), (to_chunks(q), to_chunks(logf), to_chunks(k), to_chunks(v)))
    o = o.transpose(1, 0, 3, 2, 4).reshape(b, l, h, v.shape[-1])
    return o, s_fin


def mixer(h, w_in, w_out, sinks, attn_g, hg_g, lb, rel_bias, k_buf, v_buf, s0):
    b, l = h.shape[:2]
    qa, ka, va, qh, fh, ih, gh = jnp.split(h @ w_in, SPLIT_IDX, axis=-1)
    qa = qa.reshape(b, l, ATT_HEADS, ATT_HEAD_DIM)
    ka = ka.reshape(b, l, ATT_KV_HEADS, ATT_HEAD_DIM)
    va = va.reshape(b, l, ATT_KV_HEADS, ATT_HEAD_DIM)
    if k_buf is None:
        o_a = attn_prompt(qa, ka, va, rel_bias, sinks)
        wb = min(WINDOW, l)
        k_new, v_new = ka[:, -wb:], va[:, -wb:]
        s0 = jnp.zeros((b, HG_HEADS, HG_KEY, HG_VAL), jnp.float32)
    else:
        o_a, k_new, v_new = attn_sample(qa, ka, va, k_buf, v_buf, rel_bias, sinks)
    q_h = jax.nn.silu(qh.astype(jnp.float32)).reshape(b, l, HG_HEADS, HG_KEY)
    f = lb + (1.0 - lb) * jax.nn.sigmoid(fh.astype(jnp.float32))
    logf = jnp.log(f).reshape(b, l, HG_HEADS, HG_KEY)
    k_h = (1.0 - f).reshape(b, l, HG_HEADS, HG_KEY)
    v_h = ih.astype(jnp.float32).reshape(b, l, HG_HEADS, HG_VAL)
    o_h, s_new = hgrn2_recurrence(q_h, logf, k_h, v_h, s0)
    o_h = o_h * lax.rsqrt(jnp.mean(o_h * o_h, axis=-1, keepdims=True) + RMS_EPS)
    o_h = o_h.reshape(b, l, HG_WIDTH) * hg_g.astype(jnp.float32) * jax.nn.silu(gh.astype(jnp.float32))
    o_a = rms_norm(o_a, attn_g)
    out = jnp.concatenate([o_a, o_h], axis=-1).astype(h.dtype) @ w_out
    return out, k_new, v_new, s_new


def conv_ffn(h, w_in, conv_w, conv_b, w_out, prev):
    b, l = h.shape[:2]
    a, g = jnp.split(h @ w_in, 2, axis=-1)
    if prev is None:
        prev = jnp.zeros((b, CONV_W - 1, D_FF), a.dtype)
    ap = jnp.concatenate([prev.astype(a.dtype), a], axis=1)
    ac = conv_b + ap[:, 0:l] * conv_w[0]
    for j in range(1, CONV_W):
        ac = ac + ap[:, j:j + l] * conv_w[j]
    y = (jax.nn.silu(ac) * g) @ w_out
    return y, ap[:, -(CONV_W - 1):]


def layer(x, lp, lb, rel_bias, k_buf, v_buf, s0, conv_prev):
    n1, w_in, sinks, attn_g, hg_g, w_o, n2, wf_in, cw, cb, wf_out = lp
    mix, k_new, v_new, s_new = mixer(rms_norm(x, n1), w_in, w_o, sinks, attn_g, hg_g, lb, rel_bias, k_buf, v_buf, s0)
    x = x + mix
    ff, c_new = conv_ffn(rms_norm(x, n2), wf_in, cw, cb, wf_out, conv_prev)
    x = x + ff
    return x, k_new, v_new, s_new, c_new


def setup_inputs(seed: int = 0) -> dict:
    key = jax.random.key(seed)
    ks = jax.random.split(key, 24)
    f32 = jnp.float32

    def nrm(k, shape, scale):
        return jax.random.normal(k, shape, f32) * scale

    win = min(WINDOW, PAST_LEN)
    return {
        'x_prompt': nrm(ks[0], (BATCH, SEQ, D_MODEL), 1.0),
        'x_sample': nrm(ks[1], (DEC_BATCH, DEC_SEQ, D_MODEL), 1.0),
        'cache_k_win': nrm(ks[2], (DEPTH, DEC_BATCH, win, ATT_KV_HEADS, ATT_HEAD_DIM), 1.0),
        'cache_v_win': nrm(ks[3], (DEPTH, DEC_BATCH, win, ATT_KV_HEADS, ATT_HEAD_DIM), 1.0),
        'state_hgrn': nrm(ks[4], (DEPTH, DEC_BATCH, HG_HEADS, HG_KEY, HG_VAL), 0.3),
        'state_conv': nrm(ks[5], (DEPTH, DEC_BATCH, CONV_W - 1, D_FF), 1.0),
        'norm1_g': 1.0 + nrm(ks[6], (DEPTH, D_MODEL), 0.01),
        'w_in': nrm(ks[7], (DEPTH, D_MODEL, PROJ_WIDTH), D_MODEL ** -0.5),
        'attn_sinks': nrm(ks[8], (DEPTH, ATT_HEADS), 0.5),
        'rel_bias': nrm(ks[9], (NUM_BUCKETS, ATT_HEADS), 0.1),
        'lb_gamma': nrm(ks[10], (DEPTH + 1, HG_FDIM), 0.1),
        'attn_out_g': 1.0 + nrm(ks[11], (DEPTH, ATT_WIDTH), 0.01),
        'hg_out_g': 1.0 + nrm(ks[12], (DEPTH, HG_WIDTH), 0.01),
        'w_out': nrm(ks[13], (DEPTH, MIX_WIDTH, D_MODEL), MIX_WIDTH ** -0.5),
        'norm2_g': 1.0 + nrm(ks[14], (DEPTH, D_MODEL), 0.01),
        'w_ffn_in': nrm(ks[15], (DEPTH, D_MODEL, 2 * D_FF), D_MODEL ** -0.5),
        'conv_w': nrm(ks[16], (DEPTH, CONV_W, D_FF), CONV_W ** -0.5),
        'conv_b': nrm(ks[17], (DEPTH, D_FF), 0.01),
        'w_ffn_out': nrm(ks[18], (DEPTH, D_FF, D_MODEL), D_FF ** -0.5),
        'final_g': 1.0 + nrm(ks[19], (D_MODEL,), 0.01),
    }


def reference(x_prompt, x_sample, cache_k_win, cache_v_win, state_hgrn, state_conv,
              norm1_g, w_in, attn_sinks, rel_bias, lb_gamma, attn_out_g, hg_out_g, w_out,
              norm2_g, w_ffn_in, conv_w, conv_b, w_ffn_out, final_g):
    lb_all = jnp.cumsum(jax.nn.softmax(lb_gamma.astype(jnp.float32), axis=0), axis=0)
    xp, xs = x_prompt, x_sample
    kp_l, vp_l, sp_l, cp_l = [], [], [], []
    ks_l, vs_l, ss_l, cs_l = [], [], [], []
    for l in range(DEPTH):
        lp = (norm1_g[l], w_in[l], attn_sinks[l], attn_out_g[l], hg_out_g[l], w_out[l],
              norm2_g[l], w_ffn_in[l], conv_w[l], conv_b[l], w_ffn_out[l])
        xp, kp, vp, sp, cp = layer(xp, lp, lb_all[l], rel_bias, None, None, None, None)
        xs, ks_, vs_, ss_, cs_ = layer(xs, lp, lb_all[l], rel_bias, cache_k_win[l], cache_v_win[l],
                                       state_hgrn[l], state_conv[l])
        kp_l.append(kp); vp_l.append(vp); sp_l.append(sp); cp_l.append(cp)
        ks_l.append(ks_); vs_l.append(vs_); ss_l.append(ss_); cs_l.append(cs_)
    y_prompt = rms_norm(xp, final_g)
    y_sample = rms_norm(xs, final_g)
    return (y_prompt, y_sample,
            jnp.stack(kp_l), jnp.stack(vp_l), jnp.stack(sp_l), jnp.stack(cp_l),
            jnp.stack(ks_l), jnp.stack(vs_l), jnp.stack(ss_l), jnp.stack(cs_l))
```

```cpp
#ifndef EMU
#include <hip/hip_runtime.h>
#endif
#include <cstdio>
#include <cstdint>

#ifndef CFG_SEQ
#define CFG_SEQ 8192
#endif
#ifndef CFG_DB
#define CFG_DB 128
#endif
#ifndef MK_N_LAUNCHES
#define MK_N_LAUNCHES 9
#endif

#ifdef EMU
#define LAS
#define GAS
#define ASMV(...) ((void)0)
#else
#define LAS __attribute__((address_space(3)))
#define GAS __attribute__((address_space(1)))
#define ASMV(...) asm volatile(__VA_ARGS__)
#endif

typedef unsigned short bf16_t;
typedef short bf16x8 __attribute__((ext_vector_type(8)));
typedef float f32x4 __attribute__((ext_vector_type(4)));
typedef unsigned u32x4 __attribute__((ext_vector_type(4)));
typedef unsigned u32x2 __attribute__((ext_vector_type(2)));

constexpr int BATCH = 2, SEQ = CFG_SEQ, DM = 1024, DB = CFG_DB, DS = 4;
constexpr int MP = BATCH * SEQ, MS = DB * DS, MT = MP + MS;
constexpr int NPROJ = 2816, DFF = 2816, NFF2 = 2 * DFF;
constexpr int PANELS = MT / 256, PP = MP / 256, PPB = SEQ / 256;
constexpr int NSEG = SEQ / 256;
constexpr int HUNITS = BATCH * 4 * NSEG;
constexpr float RMS_EPS = 1e-6f;
static_assert(SEQ % 256 == 0 && MS % 256 == 0, "row panels");
constexpr size_t O_YP = 0, O_YS = O_YP + (size_t)MP * DM, O_KP = O_YS + (size_t)MS * DM, O_VP = O_KP + (size_t)BATCH * 128 * 128, O_HP = O_VP + (size_t)BATCH * 128 * 128,
                 O_CP = O_HP + (size_t)BATCH * 4 * 128 * 128, O_KS = O_CP + (size_t)BATCH * 2 * DFF, O_VS = O_KS + (size_t)DB * 128 * 128, O_HS = O_VS + (size_t)DB * 128 * 128,
                 O_CS = O_HS + (size_t)DB * 4 * 128 * 128, O_END = O_CS + (size_t)DB * 2 * DFF;
constexpr size_t al256(size_t x) { return (x + 255) / 256 * 256; }
constexpr size_t WS_CTL = 0, CTL_BYTES = 1u << 20;
constexpr size_t WS_W1T = WS_CTL + CTL_BYTES;
constexpr size_t WS_WOT = WS_W1T + (size_t)NPROJ * DM * 2;
constexpr size_t WS_W3T = WS_WOT + (size_t)DM * DM * 2;
constexpr size_t WS_W4T = WS_W3T + (size_t)NFF2 * DM * 2;
constexpr size_t WS_SSQ2 = WS_W4T + (size_t)DM * DFF * 2;
constexpr size_t WS_SSQ3 = WS_SSQ2 + al256((size_t)MT * 16 * 4);
constexpr size_t WS_HDEC = WS_SSQ3 + al256((size_t)MT * 16 * 4);
constexpr size_t WS_XN = WS_HDEC + al256((size_t)HUNITS * 128 * 4);
constexpr size_t WS_QA = WS_XN + (size_t)MT * DM * 2;
constexpr size_t WS_KA = WS_QA + (size_t)MT * 512 * 2;
constexpr size_t WS_VA = WS_KA + (size_t)MT * 128 * 2;
constexpr size_t WS_QH = WS_VA + (size_t)MT * 128 * 2;
constexpr size_t WS_LF = WS_QH + (size_t)MT * 512 * 2;
constexpr size_t WS_VH = WS_LF + (size_t)MT * 512 * 4;
constexpr size_t WS_GH = WS_VH + (size_t)MT * 512 * 2;
constexpr size_t WS_MIX = WS_GH + (size_t)MT * 512 * 2;
constexpr size_t WS_HSUM = WS_MIX + (size_t)MT * DM * 2;
constexpr size_t WS_HPRE = WS_HSUM + (size_t)HUNITS * 16384 * 4;
constexpr size_t WS_END = WS_HPRE + (size_t)HUNITS * 16384 * 4;
constexpr size_t WS_H = WS_QA;
static_assert(WS_H + (size_t)MT * DFF * 2 <= WS_GH + (size_t)MT * 512 * 2 + (size_t)MT * DM * 2, "H overlay must end inside dead buffers");
static_assert(WS_END <= ((size_t)256 << 20), "workspace map exceeds 256 MiB");
constexpr int RING_BYTES = 131072, EX_OFF = RING_BYTES, LDS_BYTES = 147456, MISC_OFF = LDS_BYTES - 128;
constexpr int NWAVES = 8, NTHR = 512;

__device__ __forceinline__ unsigned f2bf(float f) { unsigned u = __builtin_bit_cast(unsigned, f); return (u + 0x7fffu + ((u >> 16) & 1u)) >> 16; }
__device__ __forceinline__ unsigned pk2(float lo, float hi) {
#ifdef EMU
    return f2bf(lo) | (f2bf(hi) << 16);
#else
    typedef float f32x2_t __attribute__((ext_vector_type(2))); typedef __bf16 bf16x2_t __attribute__((ext_vector_type(2)));
    f32x2_t v = {lo, hi}; bf16x2_t b = __builtin_convertvector(v, bf16x2_t); return __builtin_bit_cast(unsigned, b);
#endif
}
__device__ __forceinline__ float bf2f(unsigned h) { return __builtin_bit_cast(float, h << 16); }
__device__ __forceinline__ float bflo(unsigned w) { return __builtin_bit_cast(float, w << 16); }
__device__ __forceinline__ float bfhi(unsigned w) { return __builtin_bit_cast(float, w & 0xffff0000u); }
__device__ __forceinline__ float fexp(float x) { return __builtin_amdgcn_exp2f(x * 1.4426950408889634f); }
__device__ __forceinline__ float frcp(float x) { return __builtin_amdgcn_rcpf(x); }
__device__ __forceinline__ float fsigmoid(float x) { return frcp(1.0f + fexp(-x)); }
__device__ __forceinline__ float fsilu(float x) { return x * frcp(1.0f + fexp(-x)); }
__device__ __forceinline__ float frsqrt(float x) { return 1.0f / sqrtf(x); }
__device__ __forceinline__ float wave_sum(float v) {
#pragma unroll
    for (int o = 1; o < 64; o <<= 1) v += __shfl_xor(v, o);
    return v;
}
#ifdef EMU
#define LDS_WAIT() emu::wave_sync()
#else
#define LDS_WAIT() ASMV("s_waitcnt lgkmcnt(0)" ::: "memory")
#endif
#define VM_WAIT() ASMV("s_waitcnt vmcnt(0)" ::: "memory")
#ifdef EMU
#define LAUNDER(x) ((void)0)
#else
#define LAUNDER(x) asm volatile("" : "+v"(x))
#endif
#define RAW_BAR() do { ASMV("s_waitcnt lgkmcnt(0)" ::: "memory"); __builtin_amdgcn_s_barrier(); ASMV("" ::: "memory"); } while (0)

namespace pg8 {
constexpr int BM = 256, BK = 64, HALF = 128, HTB = HALF * BK * 2, STAGE_BYTES = 8 * HTB, NXCD = 8, WGM = 8;
__host__ __device__ __forceinline__ int lds_byte(int r, int c) { const int st = (r >> 4) * 2 + (c >> 5), rr = r & 15, cc = c & 31, ob = rr * 64 + cc * 2; return st * 1024 + (ob ^ (((ob >> 9) & 1) << 5)); }
__host__ __device__ __forceinline__ void stage_rc(int b, int& R, int& C) { const int st = b / 1024, sb = b % 1024, swz = sb ^ (((sb >> 9) & 1) << 5); R = (st >> 1) * 16 + swz / 64; C = (st & 1) * 32 + (swz % 64) / 2; }
__host__ __device__ __forceinline__ int perm32(int rho) { const int n = rho >> 4, i = rho & 15; return 8 * (i >> 2) + 4 * n + (i & 3); }
struct Unit { int pm, pn, aux; };
struct Gemm { const bf16_t* A; const bf16_t* Bt; int M, N, K; };
struct StaticOrder {
    int nM, nN, nwg, G, c;
    __host__ __device__ void init(int M, int N, int G_, int c_) { nM = M / BM; nN = N / BM; nwg = nM * nN; G = G_; c = c_; }
    __host__ __device__ bool next(int i, Unit& u) const {
        const long L = (long)i * G + c; if (L >= nwg) return false;
        int wgid = (int)L; { const int q = nwg / NXCD, r = nwg % NXCD, xcd = wgid % NXCD, off = wgid / NXCD; wgid = (xcd < r ? xcd * (q + 1) : r * (q + 1) + (xcd - r) * q) + off; }
        const int nig = WGM * nN, gid = wgid / nig, fm = gid * WGM, gsz = (nM - fm) < WGM ? (nM - fm) : WGM;
        u.pm = fm + ((wgid % nig) % gsz); u.pn = (wgid % nig) / gsz; u.aux = 0; return true;
    }
    __device__ __forceinline__ void a_ready(const Unit&) const {}
    __device__ __forceinline__ void done(const Unit&) const {}
};
struct RunOrder {
    int nM, nN, G, c, rpc;
#ifndef CFG_RUNLEN
#define CFG_RUNLEN 6
#endif
    static constexpr int RUNLEN = CFG_RUNLEN;
    __host__ __device__ void init(int M, int N, int G_, int c_) { nM = M / BM; nN = N / BM; G = G_; c = c_; rpc = (nM + RUNLEN - 1) / RUNLEN; }
    __host__ __device__ bool next(int i, Unit& u) const {
        const int NR = rpc * nN;
        for (int r = c; r < NR; r += G) { const int ri = r % rpc, len = (nM - RUNLEN * ri) < RUNLEN ? (nM - RUNLEN * ri) : RUNLEN;
            if (i < len) { u.pm = RUNLEN * ri + i; u.pn = r / rpc; u.aux = i; return true; } i -= len; }
        return false;
    }
    __device__ __forceinline__ void a_ready(const Unit&) const {}
    __device__ __forceinline__ void done(const Unit&) const {}
};

#ifdef EMU
template <class Epi, class Sched, bool ALIGN_EPI = false, bool SP2 = false>
inline void gemm_phase(LAS unsigned char* lds, const Gemm g, const Sched& S, const Epi& E) {
    const int tid = threadIdx.x, wid = tid >> 6, lane = tid & 63, wr = wid >> 2, wc = wid & 3, fr = lane & 15, fq = lane >> 4;
    Unit cur;
    for (int ui = 0; S.next(ui, cur); ++ui) {
        f32x4 acc[2][2][4][2];
        for (int ai = 0; ai < 2; ++ai) for (int bj = 0; bj < 2; ++bj) for (int m = 0; m < 4; ++m) for (int n = 0; n < 2; ++n) for (int i = 0; i < 4; ++i) {
            const size_t row = (size_t)cur.pm * 256 + ai * 128 + wr * 64 + m * 16 + fr;
            const size_t col = (size_t)cur.pn * 256 + bj * 128 + wc * 32 + (Epi::PERM ? 8 * fq + 4 * n + i : 16 * n + 4 * fq + i);
            const bf16_t* a = g.A + row * g.K; const bf16_t* b = g.Bt + col * g.K; float s = 0.f;
            for (int k = 0; k < g.K; ++k) s += __builtin_bit_cast(float, (unsigned)a[k] << 16) * __builtin_bit_cast(float, (unsigned)b[k] << 16);
            acc[ai][bj][m][n][i] = s;
        }
        E(acc, cur, wr, wc, fr, fq);
    }
    __syncthreads();
}
#else
template <class Epi, class Sched, bool ALIGN_EPI = false, bool SP2 = false>
__device__ __forceinline__ void gemm_phase(LAS unsigned char* lds, const Gemm g, const Sched& S, const Epi& E) {
    const int tid = threadIdx.x, wid = __builtin_amdgcn_readfirstlane(tid >> 6), lane = tid & 63, wr = wid >> 2, wc = wid & 3, fr = lane & 15, fq = lane >> 4;
    const int K = g.K, nt = K / BK;
    unsigned voffA[2], voffB[2];
#pragma unroll
    for (int i = 0; i < 2; ++i) { int R, C; stage_rc(tid * 16 + i * 8192, R, C); const int Rb = Epi::PERM ? ((R & ~31) + perm32(R & 31)) : R;
        voffA[i] = (unsigned)(R * K + C) * 2u; voffB[i] = (unsigned)(Rb * K + C) * 2u; }
    const size_t kstep = (size_t)(BK * 2);
    const size_t hstep = (size_t)HALF * K * 2;
    const size_t tstep = 2 * hstep;
    const unsigned ldsw = (unsigned)wid * 1024u;
    const int aoff = lds_byte(wr * 64 + fr, fq * 8), boff = lds_byte(wc * 32 + fr, fq * 8);
#define PG8_SA(b, h) (((b) * 2 + (h)) * HTB)
#define PG8_SB(b, h) ((4 + (b) * 2 + (h)) * HTB)
#define PG8_STAGE(bufoff, gbase, voff) do { _Pragma("unroll") for (int _i = 0; _i < 2; ++_i) \
        __builtin_amdgcn_global_load_lds((const unsigned*)((const char*)(gbase) + (voff)[_i]), (LAS unsigned*)(lds + (bufoff) + ldsw + _i * 8192), 16, 0, 0); } while (0)
#define PG8_LDA(dst, b, h) do { _Pragma("unroll") for (int m = 0; m < 4; ++m) _Pragma("unroll") for (int k = 0; k < 2; ++k) dst[m][k] = *(const LAS bf16x8*)(lds + PG8_SA(b, h) + aoff + m * 2048 + k * 1024); } while (0)
#define PG8_LDB(dst, b, h) do { _Pragma("unroll") for (int n = 0; n < 2; ++n) _Pragma("unroll") for (int k = 0; k < 2; ++k) dst[n][k] = *(const LAS bf16x8*)(lds + PG8_SB(b, h) + boff + n * 2048 + k * 1024); } while (0)
#define PG8_MMA(ai, bj, At, Bt) do { __builtin_amdgcn_s_setprio(1); _Pragma("unroll") for (int m = 0; m < 4; ++m) _Pragma("unroll") for (int n = 0; n < 2; ++n) _Pragma("unroll") for (int k = 0; k < 2; ++k) \
        acc[ai][bj][m][n] = __builtin_amdgcn_mfma_f32_16x16x32_bf16(Bt[n][k], At[m][k], acc[ai][bj][m][n], 0, 0, 0); __builtin_amdgcn_s_setprio(0); } while (0)
#define PG8_WAIT_V(n) asm volatile("s_waitcnt vmcnt(" #n ")" ::: "memory")
#define PG8_WAIT_L(n) asm volatile("s_waitcnt lgkmcnt(" #n ")" ::: "memory")
#define PG8_BAR __builtin_amdgcn_s_barrier()
#define PG8_SCHED __builtin_amdgcn_sched_barrier(0)
    Unit cur, nxt; int ui = 0;
    if (!S.next(0, cur)) return;
    f32x4 acc[2][2][4][2];
#pragma unroll
    for (int a = 0; a < 2; ++a)
#pragma unroll
        for (int b = 0; b < 2; ++b)
#pragma unroll
            for (int m = 0; m < 4; ++m)
#pragma unroll
                for (int n = 0; n < 2; ++n) acc[a][b][m][n] = (f32x4){0.f, 0.f, 0.f, 0.f};
    bf16x8 At[4][2], B0[2][2], B1[2][2];
    const char* cA = (const char*)g.A + (size_t)cur.pm * tstep; const char* cB = (const char*)g.Bt + (size_t)cur.pn * tstep;
    S.a_ready(cur);
    if constexpr (SP2) {
        PG8_STAGE(PG8_SB(0, 0), cB, voffB); PG8_STAGE(PG8_SB(0, 1), cB + hstep, voffB); PG8_STAGE(PG8_SA(0, 0), cA, voffA); PG8_STAGE(PG8_SA(0, 1), cA + hstep, voffA);
        if (wr == 1) PG8_BAR;
        PG8_WAIT_V(2); PG8_BAR;
        PG8_STAGE(PG8_SB(1, 0), cB + kstep, voffB); PG8_STAGE(PG8_SA(1, 0), cA + kstep, voffA); PG8_STAGE(PG8_SB(1, 1), cB + hstep + kstep, voffB);
        PG8_WAIT_V(6); PG8_BAR;
    } else {
        PG8_STAGE(PG8_SB(0, 0), cB, voffB); PG8_STAGE(PG8_SA(0, 0), cA, voffA); PG8_STAGE(PG8_SB(0, 1), cB + hstep, voffB); PG8_STAGE(PG8_SA(0, 1), cA + hstep, voffA);
        if (wr == 1) PG8_BAR;
        PG8_WAIT_V(4); PG8_BAR;
        PG8_STAGE(PG8_SB(1, 0), cB + kstep, voffB); PG8_STAGE(PG8_SA(1, 0), cA + kstep, voffA); PG8_STAGE(PG8_SB(1, 1), cB + hstep + kstep, voffB);
        PG8_WAIT_V(6); PG8_BAR;
    }
    for (;;) {
        const bool has_next = S.next(ui + 1, nxt);
        const char* nA = has_next ? (const char*)g.A + (size_t)nxt.pm * tstep : cA; const char* nB = has_next ? (const char*)g.Bt + (size_t)nxt.pn * tstep : cB;
        for (int t = 0; t < nt; t += 2) {
            const bool last = (t == nt - 2);
            const char* a1 = cA + (size_t)(t + 1) * kstep;
            const char* a2 = last ? nA : cA + (size_t)(t + 2) * kstep; const char* b2 = last ? nB : cB + (size_t)(t + 2) * kstep;
            const char* a3 = a2 + kstep; const char* b3 = b2 + kstep;
            if (last && has_next) S.a_ready(nxt);
            if constexpr (SP2) {
            PG8_LDB(B0, 0, 0); PG8_LDB(B1, 0, 1); PG8_SCHED; PG8_LDA(At, 0, 0); PG8_STAGE(PG8_SA(1, 1), a1 + hstep, voffA);
            PG8_WAIT_V(8); PG8_WAIT_L(0); PG8_BAR; PG8_MMA(0, 0, At, B0); PG8_MMA(0, 1, At, B1); PG8_BAR; PG8_SCHED;
            PG8_LDA(At, 0, 1); PG8_STAGE(PG8_SB(0, 0), b2, voffB); PG8_STAGE(PG8_SB(0, 1), b2 + hstep, voffB); PG8_STAGE(PG8_SA(0, 0), a2, voffA);
            PG8_WAIT_V(8); PG8_WAIT_L(0); PG8_BAR; PG8_MMA(1, 0, At, B0); PG8_MMA(1, 1, At, B1); PG8_BAR; PG8_SCHED;
            PG8_LDB(B0, 1, 0); PG8_LDB(B1, 1, 1); PG8_SCHED; PG8_LDA(At, 1, 0); PG8_STAGE(PG8_SA(0, 1), a2 + hstep, voffA);
            PG8_WAIT_V(8); PG8_WAIT_L(0); PG8_BAR; PG8_MMA(0, 0, At, B0); PG8_MMA(0, 1, At, B1); PG8_BAR; PG8_SCHED;
            PG8_LDA(At, 1, 1); PG8_STAGE(PG8_SB(1, 0), b3, voffB); PG8_STAGE(PG8_SB(1, 1), b3 + hstep, voffB); PG8_STAGE(PG8_SA(1, 0), a3, voffA);
            PG8_WAIT_V(8); PG8_WAIT_L(0); PG8_BAR; PG8_MMA(1, 0, At, B0); PG8_MMA(1, 1, At, B1); PG8_BAR; PG8_SCHED;
            } else {
            PG8_LDB(B0, 0, 0); PG8_SCHED; PG8_LDA(At, 0, 0); PG8_STAGE(PG8_SA(1, 1), a1 + hstep, voffA);
            PG8_WAIT_L(8); PG8_BAR; PG8_WAIT_L(0); PG8_MMA(0, 0, At, B0); PG8_BAR; PG8_SCHED;
            PG8_LDB(B1, 0, 1); PG8_STAGE(PG8_SB(0, 0), b2, voffB);
            PG8_BAR; PG8_WAIT_L(0); PG8_MMA(0, 1, At, B1); PG8_BAR;
            PG8_LDA(At, 0, 1); PG8_STAGE(PG8_SA(0, 0), a2, voffA);
            PG8_BAR; PG8_WAIT_L(0); PG8_MMA(1, 0, At, B0); PG8_BAR; PG8_SCHED;
            PG8_STAGE(PG8_SB(0, 1), b2 + hstep, voffB);
            PG8_WAIT_V(6); PG8_BAR; PG8_MMA(1, 1, At, B1); PG8_BAR;
            PG8_LDB(B0, 1, 0); PG8_SCHED; PG8_LDA(At, 1, 0); PG8_STAGE(PG8_SA(0, 1), a2 + hstep, voffA);
            PG8_WAIT_L(8); PG8_BAR; PG8_WAIT_L(0); PG8_MMA(0, 0, At, B0); PG8_BAR; PG8_SCHED;
            PG8_LDB(B1, 1, 1); PG8_STAGE(PG8_SB(1, 0), b3, voffB);
            PG8_BAR; PG8_WAIT_L(0); PG8_MMA(0, 1, At, B1); PG8_BAR;
            PG8_LDA(At, 1, 1); PG8_STAGE(PG8_SA(1, 0), a3, voffA);
            PG8_BAR; PG8_WAIT_L(0); PG8_MMA(1, 0, At, B0); PG8_BAR; PG8_SCHED;
            PG8_STAGE(PG8_SB(1, 1), b3 + hstep, voffB);
            PG8_WAIT_V(6); PG8_BAR; PG8_MMA(1, 1, At, B1); PG8_BAR;
            }
        }
        if constexpr (ALIGN_EPI) { if (wr == 0) PG8_BAR; }
        if constexpr (!Epi::AFTER_DRAIN) { E(acc, cur, wr, wc, fr, fq); S.done(cur); }
        if (!has_next) break;
#pragma unroll
        for (int a = 0; a < 2; ++a)
#pragma unroll
            for (int b = 0; b < 2; ++b)
#pragma unroll
                for (int m = 0; m < 4; ++m)
#pragma unroll
                    for (int n = 0; n < 2; ++n) acc[a][b][m][n] = (f32x4){0.f, 0.f, 0.f, 0.f};
        cur = nxt; cA = nA; cB = nB; ++ui;
        if constexpr (ALIGN_EPI) { if (wr == 1) PG8_BAR; }
    }
    PG8_WAIT_V(0);
    if constexpr (!ALIGN_EPI) { if (wr == 0) PG8_BAR; }
    PG8_BAR;
#undef PG8_SA
#undef PG8_SB
#undef PG8_STAGE
#undef PG8_LDA
#undef PG8_LDB
#undef PG8_MMA
#undef PG8_WAIT_V
#undef PG8_WAIT_L
#undef PG8_BAR
#undef PG8_SCHED
}
#endif
}

struct Args { const float* in[20]; float* out; unsigned char* ws; int ph_lo, ph_hi, li, pad; };
struct Frame {
    LAS unsigned char* lds;
    int tid, lane, wave, vcu, G;
    const float *xp, *xs, *ck, *cv, *sh, *sc, *n1, *w_in, *sinks, *relb, *lbg, *ag, *hg, *w_out, *n2, *w_ffi, *cw, *cb, *w_ffo, *fg;
    float* out; unsigned char* ws;
    bf16_t *W1t, *Wot, *W3t, *W4t, *XN, *QA, *KA, *VA, *QH, *VH, *GH, *MIX, *H;
    float *LF, *SSQ2, *SSQ3, *HDEC, *HSUM, *HPRE;
};
__device__ __forceinline__ const float* xrow_ptr(const Frame& F, int row) { return row < MP ? F.xp + (size_t)row * DM : F.xs + (size_t)(row - MP) * DM; }

__device__ __forceinline__ void p0_transpose_item(const float* W, int K, int N, bf16_t* WT, int k0, int n0, int drow0, LAS float* scr, int lane) {
#pragma unroll 8
    for (int i = 0; i < 32; ++i) { const int kk = 2 * i + (lane >> 5); scr[kk * 33 + (lane & 31)] = W[(size_t)(k0 + kk) * N + n0 + (lane & 31)]; }
    LDS_WAIT(); ASMV("" ::: "memory");
    const int c = lane & 7;
#pragma unroll
    for (int j = 0; j < 4; ++j) { const int n = (lane >> 3) + 8 * j; const LAS float* s = scr + (8 * c) * 33 + n;
        u32x4 o; o.x = pk2(s[0 * 33], s[1 * 33]); o.y = pk2(s[2 * 33], s[3 * 33]); o.z = pk2(s[4 * 33], s[5 * 33]); o.w = pk2(s[6 * 33], s[7 * 33]);
        *(u32x4*)(WT + (size_t)(drow0 + n) * K + k0 + 8 * c) = o; }
    LDS_WAIT(); ASMV("" ::: "memory");
}
__device__ __forceinline__ void p0_prologue(Frame& F) {
    LAS float* scr = (LAS float*)(F.lds + F.wave * 16384);
    const int gw = F.vcu * NWAVES + F.wave, NGW = F.G * NWAVES;
    constexpr int I_1 = (DM / 64) * (NPROJ / 32), I_O = (DM / 64) * (DM / 32), I_3 = (DM / 64) * (NFF2 / 32), I_4 = (DFF / 64) * (DM / 32);
    constexpr int NITEMS = I_1 + I_O + I_3 + I_4;
    for (int it = gw; it < NITEMS; it += NGW) {
        int r = it;
        if (r < I_1) { const int nblk = NPROJ / 32, kb = r / nblk, nb = r % nblk; p0_transpose_item(F.w_in, DM, NPROJ, F.W1t, 64 * kb, 32 * nb, 32 * nb, scr, F.lane); continue; } r -= I_1;
        if (r < I_O) { const int nblk = DM / 32, kb = r / nblk, nb = r % nblk; p0_transpose_item(F.w_out, DM, DM, F.Wot, 64 * kb, 32 * nb, 32 * nb, scr, F.lane); continue; } r -= I_O;
        if (r < I_3) { const int nblk = NFF2 / 32, kb = r / nblk, nb = r % nblk, n0 = 32 * nb;
            const int drow = n0 < DFF ? 256 * (n0 / 128) + (n0 % 128) : 256 * ((n0 - DFF) / 128) + 128 + ((n0 - DFF) % 128);
            p0_transpose_item(F.w_ffi, DM, NFF2, F.W3t, 64 * kb, n0, drow, scr, F.lane); continue; } r -= I_3;
        { const int nblk = DM / 32, kb = r / nblk, nb = r % nblk; p0_transpose_item(F.w_ffo, DFF, DM, F.W4t, 64 * kb, 32 * nb, 32 * nb, scr, F.lane); }
    }
    for (int m = gw; m < MT; m += NGW) {
        const f32x4* xr = (const f32x4*)xrow_ptr(F, m) + F.lane; const f32x4* gr = (const f32x4*)F.n1 + F.lane;
        f32x4 v[4]; float s = 0.f;
#pragma unroll
        for (int j = 0; j < 4; ++j) { v[j] = xr[64 * j]; s += (v[j].x * v[j].x + v[j].y * v[j].y) + (v[j].z * v[j].z + v[j].w * v[j].w); }
        const float rstd = frsqrt(wave_sum(s) * (1.f / DM) + RMS_EPS);
        u32x2* o8 = (u32x2*)(F.XN + (size_t)m * DM) + F.lane;
#pragma unroll
        for (int j = 0; j < 4; ++j) { const f32x4 g = gr[64 * j]; u32x2 w; w.x = pk2(v[j].x * rstd * g.x, v[j].y * rstd * g.y); w.y = pk2(v[j].z * rstd * g.z, v[j].w * rstd * g.w); o8[64 * j] = w; }
    }
}

struct EpiInProj {
    static constexpr bool PERM = true, AFTER_DRAIN = false;
    bf16_t *QA, *KA, *VA, *QH, *VH, *GH; float* LF; float* out; const float* lbg; const float* hgg;
    __device__ __forceinline__ void operator()(f32x4 (&acc)[2][2][4][2], const pg8::Unit& u, int wr, int wc, int fr, int fq) const {
#pragma unroll
        for (int bj = 0; bj < 2; ++bj) {
            const int cseg = u.pn * 256 + bj * 128;
            const int c0 = cseg + wc * 32 + 8 * fq;
            float aux8[8];
#pragma unroll
            for (int e = 0; e < 8; ++e) aux8[e] = 0.f;
            if (cseg >= 1280 && cseg < 1792) {
#pragma unroll
                for (int e = 0; e < 8; ++e) { const int cl = c0 - 1280 + e; aux8[e] = fsigmoid(lbg[cl] - lbg[512 + cl]); }
            } else if (cseg >= 2304) {
#pragma unroll
                for (int e = 0; e < 8; ++e) aux8[e] = hgg[c0 - 2304 + e];
            }
#pragma unroll
            for (int ai = 0; ai < 2; ++ai)
#pragma unroll
                for (int m = 0; m < 4; ++m) {
                    const int row = u.pm * 256 + ai * 128 + wr * 64 + m * 16 + fr;
                    float v[8];
#pragma unroll
                    for (int n = 0; n < 2; ++n)
#pragma unroll
                        for (int i = 0; i < 4; ++i) v[4 * n + i] = acc[ai][bj][m][n][i];
                    if (cseg < 512) {
                        u32x4 w; w.x = pk2(v[0] * 0.125f, v[1] * 0.125f); w.y = pk2(v[2] * 0.125f, v[3] * 0.125f); w.z = pk2(v[4] * 0.125f, v[5] * 0.125f); w.w = pk2(v[6] * 0.125f, v[7] * 0.125f);
                        *(u32x4*)(QA + (size_t)row * 512 + c0) = w;
                    } else if (cseg < 768) {
                        const bool isk = cseg < 640; const int cl = c0 - (isk ? 512 : 640);
                        u32x4 w; w.x = pk2(v[0], v[1]); w.y = pk2(v[2], v[3]); w.z = pk2(v[4], v[5]); w.w = pk2(v[6], v[7]);
                        *(u32x4*)((isk ? KA : VA) + (size_t)row * 128 + cl) = w;
                        float* dst = nullptr;
                        if (row >= MP) { const int sb = (row - MP) >> 2, l = (row - MP) & 3; dst = out + (isk ? O_KS : O_VS) + ((size_t)sb * 128 + 124 + l) * 128 + cl; }
                        else { const int b = row / SEQ, t = row % SEQ; if (t >= SEQ - 128) dst = out + (isk ? O_KP : O_VP) + ((size_t)b * 128 + (t - (SEQ - 128))) * 128 + cl; }
                        if (dst) { *(f32x4*)dst = (f32x4){v[0], v[1], v[2], v[3]}; *(f32x4*)(dst + 4) = (f32x4){v[4], v[5], v[6], v[7]}; }
                    } else if (cseg < 1280) {
                        u32x4 w; w.x = pk2(fsilu(v[0]), fsilu(v[1])); w.y = pk2(fsilu(v[2]), fsilu(v[3])); w.z = pk2(fsilu(v[4]), fsilu(v[5])); w.w = pk2(fsilu(v[6]), fsilu(v[7]));
                        *(u32x4*)(QH + (size_t)row * 512 + (c0 - 768)) = w;
                    } else if (cseg < 1792) {
                        float lf[8];
#pragma unroll
                        for (int e = 0; e < 8; ++e) { const float lb = aux8[e]; lf[e] = __logf(lb + (1.0f - lb) * fsigmoid(v[e])); }
                        float* dst = LF + (size_t)row * 512 + (c0 - 1280);
                        *(f32x4*)dst = (f32x4){lf[0], lf[1], lf[2], lf[3]}; *(f32x4*)(dst + 4) = (f32x4){lf[4], lf[5], lf[6], lf[7]};
                    } else if (cseg < 2304) {
                        u32x4 w; w.x = pk2(v[0], v[1]); w.y = pk2(v[2], v[3]); w.z = pk2(v[4], v[5]); w.w = pk2(v[6], v[7]);
                        *(u32x4*)(VH + (size_t)row * 512 + (c0 - 1792)) = w;
                    } else {
                        u32x4 w; w.x = pk2(fsilu(v[0]) * aux8[0], fsilu(v[1]) * aux8[1]); w.y = pk2(fsilu(v[2]) * aux8[2], fsilu(v[3]) * aux8[3]);
                        w.z = pk2(fsilu(v[4]) * aux8[4], fsilu(v[5]) * aux8[5]); w.w = pk2(fsilu(v[6]) * aux8[6], fsilu(v[7]) * aux8[7]);
                        *(u32x4*)(GH + (size_t)row * 512 + (c0 - 2304)) = w;
                    }
                }
        }
    }
};

constexpr int AT_KP = 208, AT_KSTR = 144, AT_VSTR = AT_KP * 2 + 16;
constexpr int AT_K_OFF = 0, AT_V_OFF = AT_K_OFF + 2 * AT_KP * AT_KSTR, AT_B_OFF = AT_V_OFF + 2 * 64 * AT_VSTR, AT_R_OFF = AT_B_OFF + 8 * 128 * 4, AT_END = AT_R_OFF + 8 * 64 * 4;
static_assert(AT_END <= RING_BYTES, "attention LDS");
template <bool SAMPLE> __device__ __forceinline__ void attn_unit(Frame& F, int unit) {
    LAS unsigned char* Kl = F.lds + AT_K_OFF; LAS unsigned char* Vl = F.lds + AT_V_OFF; LAS float* biasT = (LAS float*)(F.lds + AT_B_OFF); LAS float* red = (LAS float*)(F.lds + AT_R_OFF);
    const int tid = F.tid, lane = F.lane, fr = lane & 15, fq = lane >> 4, h = F.wave, kvh = h >> 2;
    const int b = SAMPLE ? 0 : unit / (SEQ / 64), q0 = SAMPLE ? 0 : (unit % (SEQ / 64)) * 64, sb = unit;
    constexpr int NKEY = SAMPLE ? 160 : 208, NRT = SAMPLE ? 1 : 4;
    for (int idx = tid; idx < NKEY * 16; idx += NTHR) {
        const int j = idx >> 4, kv = (idx >> 3) & 1, c = idx & 7;
        u32x4 kw = (u32x4){0u, 0u, 0u, 0u}, vw = (u32x4){0u, 0u, 0u, 0u};
        if (SAMPLE) {
            if (j < 128) {
                const size_t off = (((size_t)sb * 128 + j) * 2 + kv) * 64 + c * 8;
                const f32x4 k0 = *(const f32x4*)(F.ck + off), k1 = *(const f32x4*)(F.ck + off + 4), v0 = *(const f32x4*)(F.cv + off), v1 = *(const f32x4*)(F.cv + off + 4);
                kw.x = pk2(k0.x, k0.y); kw.y = pk2(k0.z, k0.w); kw.z = pk2(k1.x, k1.y); kw.w = pk2(k1.z, k1.w);
                vw.x = pk2(v0.x, v0.y); vw.y = pk2(v0.z, v0.w); vw.z = pk2(v1.x, v1.y); vw.w = pk2(v1.z, v1.w);
                if (j >= 4) { const size_t o = (((size_t)sb * 128 + (j - 4)) * 2 + kv) * 64 + c * 8;
                    *(f32x4*)(F.out + O_KS + o) = k0; *(f32x4*)(F.out + O_KS + o + 4) = k1; *(f32x4*)(F.out + O_VS + o) = v0; *(f32x4*)(F.out + O_VS + o + 4) = v1; }
            } else if (j < 132) {
                const size_t row = (size_t)MP + sb * 4 + (j - 128);
                kw = *(const u32x4*)(F.KA + row * 128 + kv * 64 + c * 8); vw = *(const u32x4*)(F.VA + row * 128 + kv * 64 + c * 8);
            }
        } else {
            const int kpos = q0 - 128 + j;
            if (j < 192 && kpos >= 0) { const size_t row = (size_t)b * SEQ + kpos; kw = *(const u32x4*)(F.KA + row * 128 + kv * 64 + c * 8); vw = *(const u32x4*)(F.VA + row * 128 + kv * 64 + c * 8); }
        }
        *(LAS u32x4*)(Kl + (kv * AT_KP + j) * AT_KSTR + c * 16) = kw;
        LAS bf16_t* vt = (LAS bf16_t*)(Vl + (kv * 64 + c * 8) * AT_VSTR) + j;
        vt[0 * (AT_VSTR / 2)] = (bf16_t)(vw.x & 0xffff); vt[1 * (AT_VSTR / 2)] = (bf16_t)(vw.x >> 16); vt[2 * (AT_VSTR / 2)] = (bf16_t)(vw.y & 0xffff); vt[3 * (AT_VSTR / 2)] = (bf16_t)(vw.y >> 16);
        vt[4 * (AT_VSTR / 2)] = (bf16_t)(vw.z & 0xffff); vt[5 * (AT_VSTR / 2)] = (bf16_t)(vw.z >> 16); vt[6 * (AT_VSTR / 2)] = (bf16_t)(vw.w & 0xffff); vt[7 * (AT_VSTR / 2)] = (bf16_t)(vw.w >> 16);
    }
    for (int idx = tid; idx < 1024; idx += NTHR) {
        const int hh = idx >> 7, d = idx & 127; int bk = d;
        if (d >= 16) { bk = 16 + (int)(__log2f((float)d * 0.0625f) * (16.0f / 3.0f)); bk = bk > 31 ? 31 : bk; }
        biasT[idx] = F.relb[bk * 8 + hh];
    }
    __syncthreads();
    const LAS unsigned char* Kb = Kl + kvh * (AT_KP * AT_KSTR); const LAS unsigned char* Vb = Vl + kvh * (64 * AT_VSTR);
    const float sinkv = F.sinks[h];
#pragma unroll 1
    for (int rt = 0; rt < NRT; ++rt) {
        const size_t qrow = SAMPLE ? (size_t)MP + sb * 4 + (fr < 4 ? fr : 3) : (size_t)b * SEQ + q0 + 16 * rt + fr;
        bf16x8 qf[2];
#pragma unroll
        for (int ks = 0; ks < 2; ++ks) qf[ks] = *(const bf16x8*)(F.QA + qrow * 512 + h * 64 + ks * 32 + fq * 8);
        f32x4 s[10];
#pragma unroll
        for (int t = 0; t < 9; ++t) {
            f32x4 a = (f32x4){0.f, 0.f, 0.f, 0.f};
#pragma unroll
            for (int ks = 0; ks < 2; ++ks) { const bf16x8 kf = *(const LAS bf16x8*)(Kb + (16 * (rt + t) + fr) * AT_KSTR + ks * 64 + fq * 16); a = __builtin_amdgcn_mfma_f32_16x16x32_bf16(kf, qf[ks], a, 0, 0, 0); }
            s[t] = a;
        }
        s[9] = (f32x4){0.f, 0.f, 0.f, 0.f};
        float mx = -INFINITY;
#pragma unroll
        for (int t = 0; t < 9; ++t)
#pragma unroll
            for (int i = 0; i < 4; ++i) {
                const int j = 16 * (rt + t) + 4 * fq + i, dist = 128 + 16 * rt + fr - j;
                const bool ok = dist >= 0 && dist < 128 && (SAMPLE || (q0 - 128 + j) >= 0);
                const float bv = biasT[h * 128 + (dist & 127)];
                const float sv = ok ? s[t][i] + bv : -INFINITY; s[t][i] = sv; mx = fmaxf(mx, sv);
            }
        mx = fmaxf(mx, __shfl_xor(mx, 16)); mx = fmaxf(mx, __shfl_xor(mx, 32)); mx = fmaxf(mx, sinkv);
        float l = 0.f;
#pragma unroll
        for (int t = 0; t < 9; ++t)
#pragma unroll
            for (int i = 0; i < 4; ++i) { const float p = fexp(s[t][i] - mx); s[t][i] = p; l += p; }
        l += __shfl_xor(l, 16); l += __shfl_xor(l, 32); l += fexp(sinkv - mx);
        const float il = 1.0f / l;
        f32x4 O[4];
#pragma unroll
        for (int dt = 0; dt < 4; ++dt) O[dt] = (f32x4){0.f, 0.f, 0.f, 0.f};
#pragma unroll
        for (int pp = 0; pp < 5; ++pp) {
            u32x4 pw; pw.x = pk2(s[2 * pp][0], s[2 * pp][1]); pw.y = pk2(s[2 * pp][2], s[2 * pp][3]); pw.z = pk2(s[2 * pp + 1][0], s[2 * pp + 1][1]); pw.w = pk2(s[2 * pp + 1][2], s[2 * pp + 1][3]);
            const bf16x8 pf = __builtin_bit_cast(bf16x8, pw);
#pragma unroll
            for (int dt = 0; dt < 4; ++dt) {
                const LAS unsigned char* vrow = Vb + (16 * dt + fr) * AT_VSTR;
                const u32x2 lo = *(const LAS u32x2*)(vrow + (16 * (rt + 2 * pp) + 4 * fq) * 2), hi = *(const LAS u32x2*)(vrow + (16 * (rt + 2 * pp + 1) + 4 * fq) * 2);
                const u32x4 vw = (u32x4){lo.x, lo.y, hi.x, hi.y};
                O[dt] = __builtin_amdgcn_mfma_f32_16x16x32_bf16(__builtin_bit_cast(bf16x8, vw), pf, O[dt], 0, 0, 0);
            }
        }
        float ss = 0.f;
        const size_t orow = SAMPLE ? (size_t)MP + sb * 4 + (fr < 4 ? fr : 3) : (size_t)b * SEQ + q0 + 16 * rt + fr;
#pragma unroll
        for (int dt = 0; dt < 4; ++dt) { const f32x4 o = O[dt] * il; ss += (o[0] * o[0] + o[1] * o[1]) + (o[2] * o[2] + o[3] * o[3]);
            u32x2 w; w.x = pk2(o[0], o[1]); w.y = pk2(o[2], o[3]);
            if (!SAMPLE || fr < 4) *(u32x2*)(F.MIX + orow * DM + h * 64 + 16 * dt + 4 * fq) = w; }
        ss += __shfl_xor(ss, 16); ss += __shfl_xor(ss, 32);
        if (fq == 0) red[h * 64 + 16 * rt + fr] = ss;
    }
    __syncthreads();
#pragma unroll 1
    for (int rt = 0; rt < NRT; ++rt) {
        float tot = 0.f;
#pragma unroll
        for (int hh = 0; hh < 8; ++hh) tot += red[hh * 64 + 16 * rt + fr];
        const float rstd = frsqrt(tot * (1.0f / 512.0f) + RMS_EPS);
        const size_t orow = SAMPLE ? (size_t)MP + sb * 4 + fr : (size_t)b * SEQ + q0 + 16 * rt + fr;
        if (!SAMPLE || fr < 4) {
#pragma unroll
            for (int dt = 0; dt < 4; ++dt) {
                const int c = h * 64 + 16 * dt + 4 * fq; const f32x4 g = *(const f32x4*)(F.ag + c);
                u32x2* p = (u32x2*)(F.MIX + orow * DM + c); const u32x2 ov = *p;
                u32x2 w; w.x = pk2(bflo(ov.x) * rstd * g[0], bfhi(ov.x) * rstd * g[1]); w.y = pk2(bflo(ov.y) * rstd * g[2], bfhi(ov.y) * rstd * g[3]);
                *p = w;
            }
        }
    }
    __syncthreads();
}

constexpr int HG_QSTR = 272, HG_SSTR = 144;
constexpr int HG_QT = 0, HG_KT = HG_QT + 64 * HG_QSTR, HG_KD = HG_KT + 64 * HG_QSTR, HG_VT = HG_KD + 128 * HG_SSTR, HG_ST = HG_VT + 128 * HG_SSTR,
              HG_PART = HG_ST + 128 * HG_QSTR, HG_BLV = HG_PART + 4 * 128 * 4, HG_RMS = HG_BLV + 128 * 4, HG_END = HG_RMS + 64 * 2 * 4;
static_assert(HG_END <= RING_BYTES, "hgrn LDS");
template <bool SUMMARY> __device__ __forceinline__ void hgrn_unit(Frame& F, int unit) {
    LAS unsigned char* L = F.lds;
    LAS float* part = (LAS float*)(L + HG_PART); LAS float* blv = (LAS float*)(L + HG_BLV); LAS float* rmsb = (LAS float*)(L + HG_RMS);
    const int tid = F.tid, lane = F.lane, fr = lane & 15, fq = lane >> 4, w = F.wave;
    const int bh = unit / NSEG, seg = unit % NSEG, b = bh >> 2, h = bh & 3;
    const size_t mbase = (size_t)b * SEQ + (size_t)seg * 256;
    const int k_ = tid & 127, tq = tid >> 7;
    f32x4 S[8];
    if (SUMMARY) {
#pragma unroll
        for (int vt = 0; vt < 8; ++vt) S[vt] = (f32x4){0.f, 0.f, 0.f, 0.f};
    } else {
        const float* sp = F.HPRE + (size_t)unit * 16384;
#pragma unroll
        for (int vt = 0; vt < 8; ++vt) {
#pragma unroll
            for (int i = 0; i < 4; ++i) S[vt][i] = sp[(16 * w + 4 * fq + i) * 128 + 16 * vt + fr];
            u32x2 sw; sw.x = pk2(S[vt][0], S[vt][1]); sw.y = pk2(S[vt][2], S[vt][3]);
            *(LAS u32x2*)(L + HG_ST + (16 * vt + fr) * HG_QSTR + (16 * w + 4 * fq) * 2) = sw;
        }
    }
    float blsum = 0.f;
    for (int c = 0; c < 4; ++c) {
        const size_t mc = mbase + 64 * c;
        float lf[16], cbv[16];
        {
            const float* lp = F.LF + (mc + 16 * tq) * 512 + 128 * h + k_;
#pragma unroll
            for (int i = 0; i < 16; ++i) lf[i] = lp[(size_t)i * 512];
            float run = 0.f;
#pragma unroll
            for (int i = 0; i < 16; ++i) { run += lf[i]; cbv[i] = run; }
            part[tq * 128 + k_] = run;
        }
        __syncthreads();
        {
            float off = 0.f, bl = 0.f;
#pragma unroll
            for (int q = 0; q < 4; ++q) { const float p = part[q * 128 + k_]; bl += p; if (q < tq) off += p; }
            if (tq == 0) { blv[k_] = fexp(bl); blsum += bl; }
            unsigned kd[8];
            unsigned qh[16];
            if (!SUMMARY) { const bf16_t* qp = F.QH + (mc + 16 * tq) * 512 + 128 * h + k_;
#pragma unroll
                for (int i = 0; i < 16; ++i) qh[i] = qp[(size_t)i * 512]; }
#pragma unroll
            for (int i = 0; i < 16; i += 2) {
                const float cb0 = off + cbv[i], cb1 = off + cbv[i + 1];
                const float kk0 = 1.0f - fexp(lf[i]), kk1 = 1.0f - fexp(lf[i + 1]);
                kd[i >> 1] = pk2(kk0 * fexp(bl - cb0), kk1 * fexp(bl - cb1));
                if (!SUMMARY) {
                    LAS bf16_t* qt0 = (LAS bf16_t*)(L + HG_QT + (16 * tq + i) * HG_QSTR) + k_; LAS bf16_t* kt0 = (LAS bf16_t*)(L + HG_KT + (16 * tq + i) * HG_QSTR) + k_;
                    qt0[0] = (bf16_t)f2bf(bf2f(qh[i]) * fexp(cb0)); qt0[HG_QSTR / 2] = (bf16_t)f2bf(bf2f(qh[i + 1]) * fexp(cb1));
                    kt0[0] = (bf16_t)f2bf(kk0 * fexp(-cb0)); kt0[HG_QSTR / 2] = (bf16_t)f2bf(kk1 * fexp(-cb1));
                }
            }
            LAS u32x4* kdp = (LAS u32x4*)(L + HG_KD + k_ * HG_SSTR + tq * 32);
            kdp[0] = (u32x4){kd[0], kd[1], kd[2], kd[3]}; kdp[1] = (u32x4){kd[4], kd[5], kd[6], kd[7]};
            const bf16_t* vp = F.VH + (mc + 16 * tq) * 512 + 128 * h + k_;
            unsigned vv[8];
#pragma unroll
            for (int i = 0; i < 16; i += 2) vv[i >> 1] = (unsigned)vp[(size_t)i * 512] | ((unsigned)vp[(size_t)(i + 1) * 512] << 16);
            LAS u32x4* vtp = (LAS u32x4*)(L + HG_VT + k_ * HG_SSTR + tq * 32);
            vtp[0] = (u32x4){vv[0], vv[1], vv[2], vv[3]}; vtp[1] = (u32x4){vv[4], vv[5], vv[6], vv[7]};
        }
        __syncthreads();
        f32x4 OT[4];
        const int tt = w >> 1, vhalf = w & 1;
        if (!SUMMARY) {
            bf16x8 qf[4];
#pragma unroll
            for (int ks = 0; ks < 4; ++ks) qf[ks] = *(const LAS bf16x8*)(L + HG_QT + (16 * tt + fr) * HG_QSTR + ks * 64 + fq * 16);
#pragma unroll
            for (int jv = 0; jv < 4; ++jv) {
                f32x4 a = (f32x4){0.f, 0.f, 0.f, 0.f};
#pragma unroll
                for (int ks = 0; ks < 4; ++ks) { const bf16x8 sf = *(const LAS bf16x8*)(L + HG_ST + (16 * (4 * vhalf + jv) + fr) * HG_QSTR + ks * 64 + fq * 16); a = __builtin_amdgcn_mfma_f32_16x16x32_bf16(sf, qf[ks], a, 0, 0, 0); }
                OT[jv] = a;
            }
            f32x4 AT[4];
#pragma unroll
            for (int st = 0; st < 4; ++st) {
                f32x4 a = (f32x4){0.f, 0.f, 0.f, 0.f};
                if (st <= tt) {
#pragma unroll
                    for (int ks = 0; ks < 4; ++ks) { const bf16x8 kf = *(const LAS bf16x8*)(L + HG_KT + (16 * st + fr) * HG_QSTR + ks * 64 + fq * 16); a = __builtin_amdgcn_mfma_f32_16x16x32_bf16(kf, qf[ks], a, 0, 0, 0); }
                    if (st == tt) {
#pragma unroll
                        for (int i = 0; i < 4; ++i) if (4 * fq + i > fr) a[i] = 0.f;
                    }
                }
                AT[st] = a;
            }
#pragma unroll
            for (int p = 0; p < 2; ++p) {
                if (2 * p <= tt) {
                    u32x4 pw; pw.x = pk2(AT[2 * p][0], AT[2 * p][1]); pw.y = pk2(AT[2 * p][2], AT[2 * p][3]); pw.z = pk2(AT[2 * p + 1][0], AT[2 * p + 1][1]); pw.w = pk2(AT[2 * p + 1][2], AT[2 * p + 1][3]);
                    const bf16x8 pf = __builtin_bit_cast(bf16x8, pw);
#pragma unroll
                    for (int jv = 0; jv < 4; ++jv) {
                        const LAS unsigned char* vrow = L + HG_VT + (16 * (4 * vhalf + jv) + fr) * HG_SSTR;
                        const u32x2 lo = *(const LAS u32x2*)(vrow + (32 * p + 4 * fq) * 2), hi = *(const LAS u32x2*)(vrow + (32 * p + 16 + 4 * fq) * 2);
                        const u32x4 vw = (u32x4){lo.x, lo.y, hi.x, hi.y};
                        OT[jv] = __builtin_amdgcn_mfma_f32_16x16x32_bf16(__builtin_bit_cast(bf16x8, vw), pf, OT[jv], 0, 0, 0);
                    }
                }
            }
            float ss = 0.f;
#pragma unroll
            for (int jv = 0; jv < 4; ++jv) ss += (OT[jv][0] * OT[jv][0] + OT[jv][1] * OT[jv][1]) + (OT[jv][2] * OT[jv][2] + OT[jv][3] * OT[jv][3]);
            ss += __shfl_xor(ss, 16); ss += __shfl_xor(ss, 32);
            if (fq == 0) rmsb[(16 * tt + fr) * 2 + vhalf] = ss;
        }
        {
            f32x4 dec;
#pragma unroll
            for (int i = 0; i < 4; ++i) dec[i] = blv[16 * w + 4 * fq + i];
            bf16x8 kf[2];
#pragma unroll
            for (int ks = 0; ks < 2; ++ks) kf[ks] = *(const LAS bf16x8*)(L + HG_KD + (16 * w + fr) * HG_SSTR + ks * 64 + fq * 16);
#pragma unroll
            for (int vt = 0; vt < 8; ++vt) {
                f32x4 a = S[vt] * dec;
#pragma unroll
                for (int ks = 0; ks < 2; ++ks) { const bf16x8 vf = *(const LAS bf16x8*)(L + HG_VT + (16 * vt + fr) * HG_SSTR + ks * 64 + fq * 16); a = __builtin_amdgcn_mfma_f32_16x16x32_bf16(kf[ks], vf, a, 0, 0, 0); }
                S[vt] = a;
            }
        }
        __syncthreads();
        if (!SUMMARY) {
#pragma unroll
            for (int vt = 0; vt < 8; ++vt) { u32x2 sw; sw.x = pk2(S[vt][0], S[vt][1]); sw.y = pk2(S[vt][2], S[vt][3]);
                *(LAS u32x2*)(L + HG_ST + (16 * vt + fr) * HG_QSTR + (16 * w + 4 * fq) * 2) = sw; }
            const float rstd = frsqrt((rmsb[(16 * tt + fr) * 2] + rmsb[(16 * tt + fr) * 2 + 1]) * (1.0f / 128.0f) + RMS_EPS);
            const size_t row = mc + 16 * tt + fr;
#pragma unroll
            for (int jv = 0; jv < 4; ++jv) {
                const int cc = 128 * h + 16 * (4 * vhalf + jv) + 4 * fq;
                const u32x2 gw = *(const u32x2*)(F.GH + row * 512 + cc);
                u32x2 ow; ow.x = pk2(OT[jv][0] * rstd * bflo(gw.x), OT[jv][1] * rstd * bfhi(gw.x)); ow.y = pk2(OT[jv][2] * rstd * bflo(gw.y), OT[jv][3] * rstd * bfhi(gw.y));
                *(u32x2*)(F.MIX + row * DM + 512 + cc) = ow;
            }
        }
        __syncthreads();
    }
    if (SUMMARY) {
        float* up = F.HSUM + (size_t)unit * 16384;
#pragma unroll
        for (int vt = 0; vt < 8; ++vt)
#pragma unroll
            for (int i = 0; i < 4; ++i) up[(16 * w + 4 * fq + i) * 128 + 16 * vt + fr] = S[vt][i];
        if (tq == 0) F.HDEC[(size_t)unit * 128 + k_] = fexp(blsum);
    } else if (seg == NSEG - 1) {
        float* up = F.out + O_HP + (size_t)bh * 16384;
#pragma unroll
        for (int vt = 0; vt < 8; ++vt)
#pragma unroll
            for (int i = 0; i < 4; ++i) up[(16 * w + 4 * fq + i) * 128 + 16 * vt + fr] = S[vt][i];
    }
}

__device__ __forceinline__ void hgrn_sample_unit(Frame& F, int unit) {
    LAS float* qs = (LAS float*)F.lds; LAS float* fs = qs + 512; LAS float* ks = fs + 512; LAS float* vs = ks + 512; LAS float* op = vs + 512; LAS float* rr = op + 4 * 4 * 128;
    const int tid = F.tid, sb = unit >> 2, h = unit & 3, v = tid & 127, kq = tid >> 7;
    {
        const size_t row = (size_t)MP + sb * 4 + kq;
        const float lfv = F.LF[row * 512 + 128 * h + v], fv = fexp(lfv);
        qs[kq * 128 + v] = bf2f(F.QH[row * 512 + 128 * h + v]); fs[kq * 128 + v] = fv; ks[kq * 128 + v] = 1.0f - fv; vs[kq * 128 + v] = bf2f(F.VH[row * 512 + 128 * h + v]);
    }
    float S[32];
    const float* s0 = F.sh + ((size_t)sb * 4 + h) * 16384;
#pragma unroll
    for (int i = 0; i < 32; ++i) S[i] = s0[(32 * kq + i) * 128 + v];
    __syncthreads();
#pragma unroll
    for (int l = 0; l < 4; ++l) {
        const float vv = vs[l * 128 + v]; float o = 0.f;
#pragma unroll
        for (int i = 0; i < 32; ++i) { const int k = 32 * kq + i; S[i] = fs[l * 128 + k] * S[i] + ks[l * 128 + k] * vv; o += qs[l * 128 + k] * S[i]; }
        op[(l * 4 + kq) * 128 + v] = o;
    }
    float* s1 = F.out + O_HS + ((size_t)sb * 4 + h) * 16384;
#pragma unroll
    for (int i = 0; i < 32; ++i) s1[(32 * kq + i) * 128 + v] = S[i];
    __syncthreads();
    {
        const int l = kq; const float o = (op[(l * 4 + 0) * 128 + v] + op[(l * 4 + 1) * 128 + v]) + (op[(l * 4 + 2) * 128 + v] + op[(l * 4 + 3) * 128 + v]);
        const float ss = wave_sum(o * o);
        if (F.lane == 0) rr[F.wave] = ss;
        __syncthreads();
        const float rstd = frsqrt((rr[2 * l] + rr[2 * l + 1]) * (1.0f / 128.0f) + RMS_EPS);
        const size_t row = (size_t)MP + sb * 4 + l;
        F.MIX[row * DM + 512 + 128 * h + v] = (bf16_t)f2bf(o * rstd * bf2f(F.GH[row * 512 + 128 * h + v]));
    }
    __syncthreads();
}

template <int K, class EPI> __device__ __forceinline__ void small_gemm_unit(Frame& F, const bf16_t* A, const bf16_t* Bt, int unit, const EPI& epi) {
    const int lane = F.lane, fr = lane & 15, fq = lane >> 4, w = F.wave, rg = unit >> 4, cg = unit & 15;
    constexpr int KW = K / 8, NS = KW / 32; static_assert(KW % 32 == 0, "K split");
    f32x4 acc[2][4];
#pragma unroll
    for (int rt = 0; rt < 2; ++rt)
#pragma unroll
        for (int ct = 0; ct < 4; ++ct) acc[rt][ct] = (f32x4){0.f, 0.f, 0.f, 0.f};
    const bf16_t* ap = A + ((size_t)MP + 32 * rg + fr) * K + w * KW + fq * 8; const bf16_t* bp = Bt + ((size_t)64 * cg + fr) * K + w * KW + fq * 8;
    for (int s = 0; s < NS; ++s) {
        bf16x8 af[2], bf[4];
#pragma unroll
        for (int rt = 0; rt < 2; ++rt) af[rt] = *(const bf16x8*)(ap + (size_t)rt * 16 * K + s * 32);
#pragma unroll
        for (int ct = 0; ct < 4; ++ct) bf[ct] = *(const bf16x8*)(bp + (size_t)ct * 16 * K + s * 32);
#pragma unroll
        for (int rt = 0; rt < 2; ++rt)
#pragma unroll
            for (int ct = 0; ct < 4; ++ct) acc[rt][ct] = __builtin_amdgcn_mfma_f32_16x16x32_bf16(bf[ct], af[rt], acc[rt][ct], 0, 0, 0);
    }
    LAS float* red = (LAS float*)F.lds;
#pragma unroll
    for (int rt = 0; rt < 2; ++rt)
#pragma unroll
        for (int ct = 0; ct < 4; ++ct) *(LAS f32x4*)(red + (w * 32 + 16 * rt + fr) * 64 + 16 * ct + 4 * fq) = acc[rt][ct];
    __syncthreads();
    {
        const int r = F.tid >> 4, c4 = (F.tid & 15) * 4; f32x4 s = (f32x4){0.f, 0.f, 0.f, 0.f};
#pragma unroll
        for (int ww = 0; ww < 8; ++ww) s += *(const LAS f32x4*)(red + (ww * 32 + r) * 64 + c4);
        epi(MP + 32 * rg + r, 64 * cg + c4, cg, s);
    }
    __syncthreads();
}

struct EpiOutProj {
    static constexpr bool PERM = true, AFTER_DRAIN = false;
    const float* xp; float* X1; bf16_t* A2; const float* n2; float* ssq;
    __device__ __forceinline__ void operator()(f32x4 (&acc)[2][2][4][2], const pg8::Unit& u, int wr, int wc, int fr, int fq) const {
        f32x4 g[2][2];
#pragma unroll
        for (int bj = 0; bj < 2; ++bj)
#pragma unroll
            for (int n = 0; n < 2; ++n) g[bj][n] = *(const f32x4*)(n2 + u.pn * 256 + bj * 128 + wc * 32 + 8 * fq + 4 * n);
#pragma unroll
        for (int ai = 0; ai < 2; ++ai)
#pragma unroll
            for (int m = 0; m < 4; ++m) {
                const size_t row = (size_t)u.pm * 256 + ai * 128 + wr * 64 + m * 16 + fr; float ss = 0.f;
#pragma unroll
                for (int bj = 0; bj < 2; ++bj) {
                    const size_t off = row * DM + u.pn * 256 + bj * 128 + wc * 32 + 8 * fq;
                    const f32x4 x0 = *(const f32x4*)(xp + off) + acc[ai][bj][m][0], x1 = *(const f32x4*)(xp + off + 4) + acc[ai][bj][m][1];
                    *(f32x4*)(X1 + off) = x0; *(f32x4*)(X1 + off + 4) = x1;
                    ss += (x0[0] * x0[0] + x0[1] * x0[1]) + (x0[2] * x0[2] + x0[3] * x0[3]) + (x1[0] * x1[0] + x1[1] * x1[1]) + (x1[2] * x1[2] + x1[3] * x1[3]);
                    const f32x4 a0 = x0 * g[bj][0], a1 = x1 * g[bj][1];
                    u32x4 w; w.x = pk2(a0[0], a0[1]); w.y = pk2(a0[2], a0[3]); w.z = pk2(a1[0], a1[1]); w.w = pk2(a1[2], a1[3]);
                    *(u32x4*)(A2 + off) = w;
                }
                ss += __shfl_xor(ss, 16); ss += __shfl_xor(ss, 32);
                if (fq == 0) ssq[row * 16 + u.pn * 4 + wc] = ss;
            }
    }
};

__device__ __forceinline__ float dpp_shr1(float oldv, float src) { return __builtin_bit_cast(float, __builtin_amdgcn_update_dpp(__builtin_bit_cast(int, oldv), __builtin_bit_cast(int, src), 0x111, 0xf, 0xf, false)); }
__device__ __forceinline__ float dpp_shr2(float oldv, float src) { return __builtin_bit_cast(float, __builtin_amdgcn_update_dpp(__builtin_bit_cast(int, oldv), __builtin_bit_cast(int, src), 0x112, 0xf, 0xf, false)); }
__device__ __forceinline__ float dpp_ror1(float src) { return __builtin_bit_cast(float, __builtin_amdgcn_update_dpp(0, __builtin_bit_cast(int, src), 0x121, 0xf, 0xf, false)); }
__device__ __forceinline__ float dpp_ror2(float src) { return __builtin_bit_cast(float, __builtin_amdgcn_update_dpp(0, __builtin_bit_cast(int, src), 0x122, 0xf, 0xf, false)); }
constexpr int EX_RSTD = 0, EX_EDGE = EX_RSTD + 256 * 4, EX_HALO = EX_EDGE + 1024 * 4, EX_END = EX_HALO + 2 * 256 * 4;
static_assert(EX_OFF + EX_END <= MISC_OFF, "extra LDS region");
struct EpiFfnIn {
    static constexpr bool PERM = true, AFTER_DRAIN = false;
    bf16_t* H; const float* ssq2; const float* cw; const float* cb; const float* sc; float* out; const bf16_t* A2; const bf16_t* W3t; LAS unsigned char* ex;
    __device__ __forceinline__ void operator()(f32x4 (&acc)[2][2][4][2], const pg8::Unit& u, int wr, int wc, int fr_in, int fq_in) const {
        int lane_l = threadIdx.x & 63; LAUNDER(lane_l);
        const int fr = lane_l & 15, fq = lane_l >> 4; (void)fr_in; (void)fq_in;
        const int w = wr * 4 + wc, tid = w * 64 + lane_l;
        LAS float* rstd_l = (LAS float*)(ex + EX_RSTD); LAS float* edge = (LAS float*)(ex + EX_EDGE);
        LAS float* halo_cur = (LAS float*)(ex + EX_HALO) + (u.aux & 1) * 256; LAS float* halo_nxt = (LAS float*)(ex + EX_HALO) + ((u.aux + 1) & 1) * 256;
        const bool sample = u.pm >= PP, zero_halo = sample || (u.pm % PPB == 0), carry = u.aux > 0;
        if (tid < 256) { const float* sp = ssq2 + ((size_t)u.pm * 256 + tid) * 16; float s = 0.f;
#pragma unroll
            for (int j = 0; j < 16; j += 4) { const f32x4 t = *(const f32x4*)(sp + j); s += (t[0] + t[1]) + (t[2] + t[3]); }
            rstd_l[tid] = frsqrt(s * (1.0f / DM) + RMS_EPS); }
        if (!zero_halo && !carry) {
            const size_t R = (size_t)u.pm * 256;
            const bf16_t* ap = A2 + (R - 16 + fr) * DM + fq * 8; const bf16_t* bp = W3t + ((size_t)u.pn * 256 + 16 * w + fr) * DM + fq * 8;
            f32x4 a = (f32x4){0.f, 0.f, 0.f, 0.f};
#pragma unroll 1
            for (int s0 = 0; s0 < 32; s0 += 4) {
                bf16x8 af[4], bf[4];
#pragma unroll
                for (int s = 0; s < 4; ++s) { af[s] = *(const bf16x8*)(ap + (s0 + s) * 32); bf[s] = *(const bf16x8*)(bp + (s0 + s) * 32); }
#pragma unroll
                for (int s = 0; s < 4; ++s) a = __builtin_amdgcn_mfma_f32_16x16x32_bf16(bf[s], af[s], a, 0, 0, 0);
            }
            if (fr >= 14) { const float* sp = ssq2 + (R - 16 + fr) * 16; float s = 0.f;
#pragma unroll
                for (int j = 0; j < 16; ++j) s += sp[j];
                const float rs = frsqrt(s * (1.0f / DM) + RMS_EPS);
#pragma unroll
                for (int i = 0; i < 4; ++i) halo_cur[(fr - 14) * 128 + 16 * w + 4 * fq + i] = a[i] * rs; }
        }
        RAW_BAR();
#pragma unroll
        for (int ai = 0; ai < 2; ++ai)
#pragma unroll
            for (int m = 0; m < 4; ++m) { const float rs = rstd_l[ai * 128 + wr * 64 + m * 16 + fr];
#pragma unroll
                for (int bj = 0; bj < 2; ++bj)
#pragma unroll
                    for (int n = 0; n < 2; ++n) acc[ai][bj][m][n] = acc[ai][bj][m][n] * rs; }
        if (fr >= 14) {
#pragma unroll
            for (int ai = 0; ai < 2; ++ai)
#pragma unroll
                for (int n = 0; n < 2; ++n) { LAS float* e = edge + ((ai * 2 + wr) * 2 + (fr - 14)) * 128 + wc * 32 + 8 * fq + 4 * n; *(LAS f32x4*)e = acc[ai][0][3][n];
                    if (ai == 1 && wr == 1) *(LAS f32x4*)(halo_nxt + (fr - 14) * 128 + wc * 32 + 8 * fq + 4 * n) = acc[ai][0][3][n]; }
        }
        RAW_BAR();
        const int jc = u.pn * 128 + wc * 32 + 8 * fq;
#pragma unroll
        for (int n = 0; n < 2; ++n) {
            const int j4 = jc + 4 * n;
            const f32x4 w0 = *(const f32x4*)(cw + j4), w1 = *(const f32x4*)(cw + DFF + j4), w2 = *(const f32x4*)(cw + 2 * DFF + j4), bb = *(const f32x4*)(cb + j4);
#pragma unroll
            for (int ai = 0; ai < 2; ++ai) {
                f32x4 pv = (f32x4){0.f, 0.f, 0.f, 0.f};
                {
                    const LAS float* src = (wr == 1) ? edge + ((ai * 2 + 0) * 2) * 128 : (ai == 1 ? edge + ((0 * 2 + 1) * 2) * 128 : halo_cur);
                    const bool z = (wr == 0 && ai == 0 && zero_halo);
                    if (fr >= 14 && !z) pv = *(const LAS f32x4*)(src + (fr - 14) * 128 + wc * 32 + 8 * fq + 4 * n);
                }
#pragma unroll
                for (int m = 0; m < 4; ++m) {
                    const size_t row = (size_t)u.pm * 256 + ai * 128 + wr * 64 + m * 16 + fr;
                    const int l = fr & 3;
                    const f32x4 cur = acc[ai][0][m][n]; const f32x4 prv = (m == 0) ? pv : acc[ai][0][m == 0 ? 0 : m - 1][n];
                    f32x4 hv;
#pragma unroll
                    for (int i = 0; i < 4; ++i) {
                        float p1 = dpp_shr1(dpp_ror1(prv[i]), cur[i]), p2 = dpp_shr2(dpp_ror2(prv[i]), cur[i]);
                        if (sample) { const size_t sbb = (row - MP) >> 2; const float s0 = sc[(sbb * 2 + 0) * DFF + j4 + i], s1 = sc[(sbb * 2 + 1) * DFF + j4 + i];
                            p1 = (l >= 1) ? p1 : s1; p2 = (l >= 2) ? p2 : (l == 1 ? s1 : s0); }
                        const float ac = bb[i] + p2 * w0[i] + p1 * w1[i] + cur[i] * w2[i];
                        hv[i] = fsilu(ac) * acc[ai][1][m][n][i];
                    }
                    u32x2 hw; hw.x = pk2(hv[0], hv[1]); hw.y = pk2(hv[2], hv[3]);
                    *(u32x2*)(H + row * DFF + j4) = hw;
                    float* dst = nullptr;
                    if (sample) { if (l >= 2) dst = out + O_CS + (((row - MP) >> 2) * 2 + (l - 2)) * DFF + j4; }
                    else if ((u.pm % PPB) == PPB - 1 && ai == 1 && wr == 1 && m == 3 && fr >= 14) dst = out + O_CP + ((size_t)(u.pm / PPB) * 2 + (fr - 14)) * DFF + j4;
                    if (dst) *(f32x4*)dst = cur;
                }
            }
        }
    }
};

struct EpiFfnOut {
    static constexpr bool PERM = true, AFTER_DRAIN = false;
    float* X1; float* ssq;
    __device__ __forceinline__ void operator()(f32x4 (&acc)[2][2][4][2], const pg8::Unit& u, int wr, int wc, int fr, int fq) const {
#pragma unroll
        for (int ai = 0; ai < 2; ++ai)
#pragma unroll
            for (int m = 0; m < 4; ++m) {
                const size_t row = (size_t)u.pm * 256 + ai * 128 + wr * 64 + m * 16 + fr; float ss = 0.f;
#pragma unroll
                for (int bj = 0; bj < 2; ++bj) {
                    const size_t off = row * DM + u.pn * 256 + bj * 128 + wc * 32 + 8 * fq;
                    const f32x4 x0 = *(const f32x4*)(X1 + off) + acc[ai][bj][m][0], x1 = *(const f32x4*)(X1 + off + 4) + acc[ai][bj][m][1];
                    *(f32x4*)(X1 + off) = x0; *(f32x4*)(X1 + off + 4) = x1;
                    ss += (x0[0] * x0[0] + x0[1] * x0[1]) + (x0[2] * x0[2] + x0[3] * x0[3]) + (x1[0] * x1[0] + x1[1] * x1[1]) + (x1[2] * x1[2] + x1[3] * x1[3]);
                }
                ss += __shfl_xor(ss, 16); ss += __shfl_xor(ss, 32);
                if (fq == 0) ssq[row * 16 + u.pn * 4 + wc] = ss;
            }
    }
};

#ifndef EMU
#define XB_TMO      128
#define XB_XCNT(j)  (256  + 64 * (j))
#define XB_XSUB(j)  (1280 + 64 * (j))
#define XB_XGEN(j)  (2304 + 64 * (j))
#define XB_TOP      3328
#define XB_TOPGEN   3392
#define XCD_BAR_WORDS 3456
#define XB_SPIN_CAP (1u << 18)
__device__ __forceinline__ unsigned xb_ld(unsigned* p)              { return __hip_atomic_load(p, __ATOMIC_RELAXED, __HIP_MEMORY_SCOPE_AGENT); }
__device__ __forceinline__ unsigned xb_add(unsigned* p, unsigned v) { return __hip_atomic_fetch_add(p, v, __ATOMIC_RELAXED, __HIP_MEMORY_SCOPE_AGENT); }
__device__ __forceinline__ unsigned xb_xcc_id() { return (unsigned)__builtin_amdgcn_s_getreg((3 << 11) | 20) & 0xFu; }
#define XB_SPIN(cond, bar) do { unsigned _sp = 0; while (cond) { __builtin_amdgcn_s_sleep(1); \
    if ((++_sp & 255u) == 0u) { if (xb_ld(&(bar)[XB_TMO])) break; if (_sp > XB_SPIN_CAP) { atomicAdd(&(bar)[XB_TMO], 1u); break; } } } } while (0)
struct XcdBarrier { unsigned* bar; unsigned x; volatile LAS unsigned* st; };
__device__ __forceinline__ XcdBarrier xcd_barrier_post(unsigned* bar, volatile LAS unsigned* st) {
    XcdBarrier b; b.bar = bar; b.x = xb_xcc_id(); b.st = st;
    if (threadIdx.x == 0) (void)xb_add(&bar[XB_XCNT(b.x)], 1u);
    return b;
}
__device__ __forceinline__ void xcd_barrier_complete(unsigned* bar, unsigned x, unsigned& nloc, unsigned& nx) {
    const unsigned G = gridDim.x * gridDim.y * gridDim.z;
    unsigned sum, cnt, mine, sp = 0u;
    for (;;) {
        sum = 0u; cnt = 0u; mine = 0u;
#pragma unroll
        for (unsigned j = 0; j < 16; ++j) { const unsigned c = xb_ld(&bar[XB_XCNT(j)]); sum += c; cnt += (c > 0u) ? 1u : 0u; mine = (j == x) ? c : mine; }
        if (sum == G) break;
        __builtin_amdgcn_s_sleep(1);
        if ((++sp & 255u) == 0u) { if (xb_ld(&bar[XB_TMO])) break; if (sp > XB_SPIN_CAP) { atomicAdd(&bar[XB_TMO], 1u); break; } }
    }
    nloc = mine > 0u ? mine : 1u; nx = cnt > 0u ? cnt : 1u;
}
__device__ __forceinline__ void xcd_barrier(const XcdBarrier& b) {
    asm volatile("s_waitcnt vmcnt(0)" ::: "memory");
    __syncthreads();
    if (threadIdx.x == 0) {
        unsigned* bar = b.bar;
        __builtin_amdgcn_s_waitcnt(0);
        unsigned nloc = b.st[0], nx = b.st[1];
        if (nloc == 0u) { xcd_barrier_complete(bar, b.x, nloc, nx); b.st[0] = nloc; b.st[1] = nx; }
        const unsigned old = xb_add(&bar[XB_XSUB(b.x)], 1u);
        const unsigned gen = old / nloc;
        if (old + 1u == (gen + 1u) * nloc) {
            __builtin_amdgcn_fence(__ATOMIC_RELEASE, "agent");
            asm volatile("s_waitcnt vmcnt(0)" ::: "memory");
            const unsigned og = xb_add(&bar[XB_TOP], 1u);
            const unsigned tg = og / nx;
            if (og + 1u == (tg + 1u) * nx) xb_add(&bar[XB_TOPGEN], 1u);
            else XB_SPIN(xb_ld(&bar[XB_TOPGEN]) == tg, bar);
            __builtin_amdgcn_fence(__ATOMIC_ACQUIRE, "agent");
            xb_add(&bar[XB_XGEN(b.x)], 1u);
            asm volatile("s_waitcnt vmcnt(0)" ::: "memory");
        } else {
            XB_SPIN(xb_ld(&bar[XB_XGEN(b.x)]) == gen, bar);
            __builtin_amdgcn_fence(__ATOMIC_ACQUIRE, "agent");
            asm volatile("s_waitcnt vmcnt(0)" ::: "memory");
        }
    }
    __syncthreads();
}
#endif

constexpr int NPHASES = 9;
constexpr int CW_BAR = 4096;
#ifdef EMU
void mk_fwd(Args args) {
    unsigned char* lds = emu::B->lds;
#else
__global__ void __launch_bounds__(NTHR, 2) mk_fwd(Args args) {
    extern __shared__ __attribute__((aligned(16))) unsigned char lds[];
#endif
    Frame F;
    F.lds = (LAS unsigned char*)lds;
    F.tid = threadIdx.x; F.lane = F.tid & 63; F.wave = __builtin_amdgcn_readfirstlane(F.tid >> 6);
    F.G = gridDim.x; { const int bx = blockIdx.x; F.vcu = (F.G % 8 == 0) ? (bx % 8) * (F.G / 8) + bx / 8 : bx; }
    const float* const* in = args.in;
    F.xp = in[0]; F.xs = in[1]; F.ck = in[2]; F.cv = in[3]; F.sh = in[4]; F.sc = in[5]; F.n1 = in[6]; F.w_in = in[7]; F.sinks = in[8]; F.relb = in[9]; F.lbg = in[10];
    F.ag = in[11]; F.hg = in[12]; F.w_out = in[13]; F.n2 = in[14]; F.w_ffi = in[15]; F.cw = in[16]; F.cb = in[17]; F.w_ffo = in[18]; F.fg = in[19];
    F.out = args.out; unsigned char* ws = args.ws; F.ws = ws;
    F.W1t = (bf16_t*)(ws + WS_W1T); F.Wot = (bf16_t*)(ws + WS_WOT); F.W3t = (bf16_t*)(ws + WS_W3T); F.W4t = (bf16_t*)(ws + WS_W4T);
    F.XN = (bf16_t*)(ws + WS_XN); F.QA = (bf16_t*)(ws + WS_QA); F.KA = (bf16_t*)(ws + WS_KA); F.VA = (bf16_t*)(ws + WS_VA); F.QH = (bf16_t*)(ws + WS_QH);
    F.VH = (bf16_t*)(ws + WS_VH); F.GH = (bf16_t*)(ws + WS_GH); F.MIX = (bf16_t*)(ws + WS_MIX); F.H = (bf16_t*)(ws + WS_H);
    F.LF = (float*)(ws + WS_LF); F.SSQ2 = (float*)(ws + WS_SSQ2); F.SSQ3 = (float*)(ws + WS_SSQ3); F.HDEC = (float*)(ws + WS_HDEC); F.HSUM = (float*)(ws + WS_HSUM); F.HPRE = (float*)(ws + WS_HPRE);
    const int lo = args.ph_lo, hi = args.ph_hi;
#ifndef EMU
    volatile LAS unsigned* MISC = (volatile LAS unsigned*)(F.lds + MISC_OFF);
    if (F.tid < 32) MISC[F.tid] = 0u;
    __syncthreads();
    XcdBarrier bar; bar.bar = (unsigned*)(ws + WS_CTL) + CW_BAR + args.li * XCD_BAR_WORDS; bar.x = 0; bar.st = nullptr;
    if (hi - lo > 1) bar = xcd_barrier_post(bar.bar, MISC + 8);
#define GRID_BAR() xcd_barrier(bar)
#else
#define GRID_BAR() ((void)0)
#endif
#ifndef PH_MASK
#define PH_MASK 0x1ff
#endif
#define IN(k) ((((PH_MASK) >> (k)) & 1) && lo <= (k) && (k) < hi)
#define SEAM(k) do { if (IN(k) && IN((k) + 1)) GRID_BAR(); } while (0)

    if (IN(0)) { p0_prologue(F); SEAM(0); }
    if (IN(1)) {
        pg8::Gemm g{F.XN, F.W1t, MT, NPROJ, DM}; pg8::StaticOrder S; S.init(MT, NPROJ, F.G, (int)blockIdx.x);
        EpiInProj E{F.QA, F.KA, F.VA, F.QH, F.VH, F.GH, F.LF, F.out, F.lbg, F.hg};
        pg8::gemm_phase<EpiInProj, pg8::StaticOrder, true, true>(F.lds, g, S, E);
        SEAM(1);
    }
    if (IN(2)) {
        for (int u = F.vcu; u < HUNITS; u += F.G) hgrn_unit<true>(F, u);
        for (int u = F.vcu; u < DB; u += F.G) attn_unit<true>(F, u);
        for (int u = F.vcu; u < DB * 4; u += F.G) hgrn_sample_unit(F, u);
        SEAM(2);
    }
    if (IN(3)) {
        for (int e = F.vcu * NTHR + F.tid; e < BATCH * 4 * 16384; e += F.G * NTHR) {
            const int bh = e >> 14, kv = e & 16383, k = kv >> 7; float P = 0.f;
            for (int sg = 0; sg < NSEG; ++sg) { const size_t un = (size_t)bh * NSEG + sg; F.HPRE[un * 16384 + kv] = P; P = F.HDEC[un * 128 + k] * P + F.HSUM[un * 16384 + kv]; }
        }
        SEAM(3);
    }
    if (IN(4)) {
#ifndef NO_ATTN
        for (int u = F.vcu; u < BATCH * (SEQ / 64); u += F.G) attn_unit<false>(F, u);
#endif
#ifndef NO_HGRN
        for (int u = F.vcu; u < HUNITS; u += F.G) hgrn_unit<false>(F, u);
#endif
        SEAM(4);
    }
    if (IN(5)) {
        {
            pg8::Gemm g{F.MIX, F.Wot, MP, DM, DM}; pg8::StaticOrder S; S.init(MP, DM, F.G, (int)blockIdx.x);
            EpiOutProj E{F.xp, F.out + O_YP, F.XN, F.n2, F.SSQ2};
            pg8::gemm_phase<EpiOutProj, pg8::StaticOrder, true, true>(F.lds, g, S, E);
        }
        for (int u = F.vcu; u < (MS / 32) * 16; u += F.G)
            small_gemm_unit<DM>(F, F.MIX, F.Wot, u, [&](int row, int col, int cg, f32x4 s) {
                const size_t off = (size_t)row * DM + col; const f32x4 x1 = *(const f32x4*)(F.xs + (size_t)(row - MP) * DM + col) + s;
                *(f32x4*)(F.out + off) = x1; const f32x4 g = *(const f32x4*)(F.n2 + col); const f32x4 a = x1 * g;
                u32x2 w; w.x = pk2(a[0], a[1]); w.y = pk2(a[2], a[3]); *(u32x2*)(F.XN + off) = w;
                float ss = (x1[0] * x1[0] + x1[1] * x1[1]) + (x1[2] * x1[2] + x1[3] * x1[3]);
                ss += __shfl_xor(ss, 1); ss += __shfl_xor(ss, 2); ss += __shfl_xor(ss, 4); ss += __shfl_xor(ss, 8);
                if ((F.tid & 15) == 0) F.SSQ2[(size_t)row * 16 + cg] = ss;
            });
        SEAM(5);
    }
    if (IN(6)) {
        pg8::Gemm g{F.XN, F.W3t, MT, NFF2, DM}; pg8::RunOrder S; S.init(MT, NFF2, F.G, F.vcu);
        EpiFfnIn E{F.H, F.SSQ2, F.cw, F.cb, F.sc, F.out, F.XN, F.W3t, F.lds + EX_OFF};
        pg8::gemm_phase<EpiFfnIn, pg8::RunOrder, true, true>(F.lds, g, S, E);
        SEAM(6);
    }
    if (IN(7)) {
        {
            pg8::Gemm g{F.H, F.W4t, MP, DM, DFF}; pg8::StaticOrder S; S.init(MP, DM, F.G, (int)blockIdx.x);
            EpiFfnOut E{F.out + O_YP, F.SSQ3};
            pg8::gemm_phase<EpiFfnOut, pg8::StaticOrder, true, true>(F.lds, g, S, E);
        }
        for (int u = F.vcu; u < (MS / 32) * 16; u += F.G)
            small_gemm_unit<DFF>(F, F.H, F.W4t, u, [&](int row, int col, int cg, f32x4 s) {
                const size_t off = (size_t)row * DM + col; const f32x4 z = *(const f32x4*)(F.out + off) + s; *(f32x4*)(F.out + off) = z;
                float ss = (z[0] * z[0] + z[1] * z[1]) + (z[2] * z[2] + z[3] * z[3]);
                ss += __shfl_xor(ss, 1); ss += __shfl_xor(ss, 2); ss += __shfl_xor(ss, 4); ss += __shfl_xor(ss, 8);
                if ((F.tid & 15) == 0) F.SSQ3[(size_t)row * 16 + cg] = ss;
            });
        SEAM(7);
    }
    if (IN(8)) {
        const int gw = F.vcu * NWAVES + F.wave, NGW = F.G * NWAVES;
        for (int m = gw; m < MT; m += NGW) {
            float s = F.lane < 16 ? F.SSQ3[(size_t)m * 16 + F.lane] : 0.f; s = wave_sum(s);
            const float rstd = frsqrt(s * (1.0f / DM) + RMS_EPS);
            f32x4* zr = (f32x4*)(F.out + (size_t)m * DM) + F.lane; const f32x4* gr = (const f32x4*)F.fg + F.lane;
#pragma unroll
            for (int j = 0; j < 4; ++j) zr[64 * j] = zr[64 * j] * rstd * gr[64 * j];
        }
    }
#undef IN
#undef SEAM
}

extern "C" void kernel_launch(void* const* d_in, const int* in_sizes, int n_in, void* d_out, int out_size, void* d_ws, size_t ws_size, hipStream_t stream) {
    (void)in_sizes; (void)n_in; (void)out_size; (void)ws_size;
    Args a{};
    for (int i = 0; i < 20; ++i) a.in[i] = (const float*)d_in[i];
    a.out = (float*)d_out; a.ws = (unsigned char*)d_ws;
#ifdef EMU
    const int grid = 8;
    const char* es = getenv("EMU_STOP"); const int pstop = es ? atoi(es) : NPHASES;
    for (int p = 0; p < pstop; ++p) { a.ph_lo = p; a.ph_hi = p + 1; a.li = p; Args aa = a; emu::launch(grid, NTHR, LDS_BYTES, [aa] { mk_fwd(aa); }); fprintf(stderr, "phase %d done\n", p); }
#else
    static int grid = 0;
    if (grid == 0) {
        int dev = 0, cus = 0;
        if (hipGetDevice(&dev) != hipSuccess || hipDeviceGetAttribute(&cus, hipDeviceAttributeMultiprocessorCount, dev) != hipSuccess) { fprintf(stderr, "kernel_launch: device query failed\n"); grid = -1; return; }
        if (hipFuncSetAttribute((const void*)mk_fwd, hipFuncAttributeMaxDynamicSharedMemorySize, LDS_BYTES) != hipSuccess) { fprintf(stderr, "kernel_launch: hipFuncSetAttribute failed\n"); grid = -1; return; }
        (void)hipGetLastError();
        grid = cus;
    }
    if (grid < 0) return;
    (void)hipMemsetAsync((char*)d_ws + WS_CTL, 0, CTL_BYTES, stream);
    constexpr int NL = MK_N_LAUNCHES;
    for (int li = 0; li < NL; ++li) {
        a.ph_lo = (NL == 1) ? 0 : li; a.ph_hi = (NL == 1) ? NPHASES : li + 1; a.li = li;
        hipLaunchKernelGGL(mk_fwd, dim3(grid), dim3(NTHR), LDS_BYTES, stream, a);
    }
#endif
}
```
